# Optimizing an MI355X kernel written in HIP

```python
import jax, jax.numpy as jnp
from jax import lax
import numpy as np

D_MODEL = 1024
BATCH = 16
SEQ = 2048
DEPTH = 1

CTX_LEN = 256
GRID_W = 64
N_HEADS = 8
HEAD_DIM = 64
ATT_W = N_HEADS * HEAD_DIM
CONV_W = 512
WIN_H_MAX = 8
WIN_W = 16
Q_COLS = 16
K_COLS = 32
D_FF = 2816
CONV_K = 3
EPS = 1e-6
NEG_INF = -1e30

Q_OFF = 0
K_OFF = ATT_W
V_OFF = 2 * ATT_W
BG_OFF = 3 * ATT_W
CG_OFF = BG_OFF + CONV_W
HV_OFF = CG_OFF + CONV_W
GA_OFF = HV_OFF + CONV_W
GB_OFF = GA_OFF + D_MODEL
IN_W = GB_OFF + D_MODEL

kernel_name = "hybrid_natten_shortconv_convffn_dit"


def rmsnorm(x, g):
    x32 = x.astype(jnp.float32)
    y = x32 * lax.rsqrt(jnp.mean(x32 * x32, axis=-1, keepdims=True) + EPS)
    return (y * g.astype(jnp.float32)).astype(x.dtype)


def modulate(h, shift, scale):
    return h * (1 + scale) + shift


def heads(t):
    return t.reshape(*t.shape[:-1], N_HEADS, HEAD_DIM)


def dwconv3(x, w):
    ch = x.shape[-1]
    return lax.conv_general_dilated(
        x, w[:, None, :].astype(x.dtype), window_strides=(1,), padding=((1, 1),),
        dimension_numbers=("NWC", "WIO", "NWC"), feature_group_count=ch)


def _col_blocks():
    n_cb = GRID_W // Q_COLS
    qcol = np.arange(GRID_W).reshape(n_cb, Q_COLS)
    cs = np.clip(qcol - WIN_W // 2, 0, GRID_W - WIN_W)
    kstart = np.clip(cs[:, 0], 0, GRID_W - K_COLS)
    kcol = kstart[:, None] + np.arange(K_COLS)
    valid = (kcol[:, None, :] >= cs[:, :, None]) & (kcol[:, None, :] < cs[:, :, None] + WIN_W)
    dc = np.clip(kcol[:, None, :] - qcol[:, :, None] + WIN_W - 1, 0, 2 * WIN_W - 2)
    return kcol, valid, dc


def neighbourhood_attention(q, k, v, kc, vc, rpb):
    b, s = q.shape[:2]
    rows = s // GRID_W
    kh = min(WIN_H_MAX, rows)
    n_cb = GRID_W // Q_COLS
    kcol, valid, dc = _col_blocks()
    mask = jnp.asarray(valid)[None, :, :, None, :]
    grid = lambda t: t.reshape(b, rows, GRID_W, N_HEADS, HEAD_DIM)
    qg = jnp.moveaxis(grid(q * (HEAD_DIM ** -0.5)), 1, 0)
    kg, vg = grid(k), grid(v)

    def one_row(args):
        r, q_row = args
        rs = jnp.clip(r - kh // 2, 0, rows - kh)
        k_rows = lax.dynamic_slice_in_dim(kg, rs, kh, axis=1)
        v_rows = lax.dynamic_slice_in_dim(vg, rs, kh, axis=1)
        kb = k_rows[:, :, kcol]
        vb = v_rows[:, :, kcol]
        qb = q_row.reshape(b, n_cb, Q_COLS, N_HEADS, HEAD_DIM)
        dr = rs + jnp.arange(kh) - r + WIN_H_MAX - 1
        bias = rpb[:, dr][:, :, dc]
        bias = jnp.where(mask, jnp.transpose(bias, (0, 2, 3, 1, 4)).astype(jnp.float32), NEG_INF)
        s_win = jnp.einsum("bnqhd,brnkhd->bhnqrk", qb, kb).astype(jnp.float32) + bias
        s_win = s_win.reshape(b, N_HEADS, n_cb, Q_COLS, kh * K_COLS)
        s_ctx = jnp.einsum("bnqhd,bjhd->bhnqj", qb, kc).astype(jnp.float32)
        p = jax.nn.softmax(jnp.concatenate([s_win, s_ctx], axis=-1), axis=-1)
        p_win = p[..., :kh * K_COLS].reshape(b, N_HEADS, n_cb, Q_COLS, kh, K_COLS).astype(v.dtype)
        p_ctx = p[..., kh * K_COLS:].astype(v.dtype)
        o = (jnp.einsum("bhnqrk,brnkhd->bnqhd", p_win, vb)
             + jnp.einsum("bhnqj,bjhd->bnqhd", p_ctx, vc))
        return o.reshape(b, GRID_W, N_HEADS, HEAD_DIM)

    out = lax.map(one_row, (jnp.arange(rows), qg))
    return jnp.moveaxis(out, 0, 1).reshape(b, s, ATT_W)


def context_attention(qc, kc, vc):
    b, n = qc.shape[:2]
    s = jnp.einsum("bihd,bjhd->bhij", qc * (HEAD_DIM ** -0.5), kc).astype(jnp.float32)
    p = jax.nn.softmax(s, axis=-1).astype(vc.dtype)
    return jnp.einsum("bhij,bjhd->bihd", p, vc).reshape(b, n, ATT_W)


def merge_branches(p, attn, w_conv, w_ba, w_bb, w_o):
    bg, cg, hv = p[..., BG_OFF:CG_OFF], p[..., CG_OFF:HV_OFF], p[..., HV_OFF:GA_OFF]
    ga, gb = p[..., GA_OFF:GB_OFF], p[..., GB_OFF:IN_W]
    y_attn = attn @ w_ba
    y_conv = (bg * dwconv3(cg * hv, w_conv)) @ w_bb
    return (jax.nn.sigmoid(ga) * y_attn + jax.nn.sigmoid(gb) * y_conv) @ w_o


def conv_ffn(h, w_up, w_conv, b_conv, w_down):
    u = h @ w_up
    a, g = u[..., :D_FF], u[..., D_FF:]
    return (jax.nn.gelu(dwconv3(g, w_conv) + b_conv, approximate=True) * a) @ w_down


def setup_inputs(seed: int = 0) -> dict:
    key = jax.random.key(seed)
    ks = jax.random.split(key, 20)
    n = jax.random.normal
    f32 = jnp.float32
    return {
        "x": n(ks[0], (BATCH, SEQ, D_MODEL), f32),
        "c": n(ks[1], (BATCH, D_MODEL), f32),
        "ctx": n(ks[2], (BATCH, CTX_LEN, D_MODEL), f32),
        "c_ctx": n(ks[3], (D_MODEL,), f32),
        "w_ada": n(ks[4], (DEPTH, D_MODEL, 6 * D_MODEL), f32) * (0.5 * D_MODEL ** -0.5),
        "b_ada": n(ks[5], (DEPTH, 6 * D_MODEL), f32) * 0.01,
        "g_pre_mix": 1.0 + 0.02 * n(ks[6], (DEPTH, D_MODEL), f32),
        "g_post_mix": 1.0 + 0.02 * n(ks[7], (DEPTH, D_MODEL), f32),
        "g_pre_ffn": 1.0 + 0.02 * n(ks[8], (DEPTH, D_MODEL), f32),
        "g_post_ffn": 1.0 + 0.02 * n(ks[9], (DEPTH, D_MODEL), f32),
        "w_in": n(ks[10], (DEPTH, D_MODEL, IN_W), f32) * D_MODEL ** -0.5,
        "rpb": n(ks[11], (DEPTH, N_HEADS, 2 * WIN_H_MAX - 1, 2 * WIN_W - 1), f32) * 0.1,
        "w_short_conv": n(ks[12], (DEPTH, CONV_K, CONV_W), f32) * CONV_K ** -0.5,
        "w_branch_attn": n(ks[13], (DEPTH, ATT_W, D_MODEL), f32) * ATT_W ** -0.5,
        "w_branch_conv": n(ks[14], (DEPTH, CONV_W, D_MODEL), f32) * CONV_W ** -0.5,
        "w_out": n(ks[15], (DEPTH, D_MODEL, D_MODEL), f32) * D_MODEL ** -0.5,
        "w_up": n(ks[16], (DEPTH, D_MODEL, 2 * D_FF), f32) * D_MODEL ** -0.5,
        "w_ffn_conv": n(ks[17], (DEPTH, CONV_K, D_FF), f32) * CONV_K ** -0.5,
        "b_ffn_conv": n(ks[18], (DEPTH, D_FF), f32) * 0.01,
        "w_down": n(ks[19], (DEPTH, D_FF, D_MODEL), f32) * D_FF ** -0.5,
    }


def reference(x, c, ctx, c_ctx, w_ada, b_ada, g_pre_mix, g_post_mix, g_pre_ffn, g_post_ffn,
              w_in, rpb, w_short_conv, w_branch_attn, w_branch_conv, w_out,
              w_up, w_ffn_conv, b_ffn_conv, w_down):
    for l in range(DEPTH):
        last = l == DEPTH - 1
        mod_x = (jax.nn.silu(c) @ w_ada[l] + b_ada[l])[:, None, :]
        mod_c = jax.nn.silu(c_ctx) @ w_ada[l] + b_ada[l]
        sh1, sc1, gt1, sh2, sc2, gt2 = jnp.split(mod_x, 6, axis=-1)
        csh1, csc1, cgt1, csh2, csc2, cgt2 = jnp.split(mod_c, 6, axis=-1)

        hc = modulate(rmsnorm(ctx, g_pre_mix[l]), csh1, csc1)
        if last:
            pkv = hc @ w_in[l][:, K_OFF:BG_OFF]
            kc, vc = heads(pkv[..., :ATT_W]), heads(pkv[..., ATT_W:])
        else:
            pc = hc @ w_in[l]
            kc, vc = heads(pc[..., K_OFF:V_OFF]), heads(pc[..., V_OFF:BG_OFF])
            attn_c = context_attention(heads(pc[..., Q_OFF:K_OFF]), kc, vc)
            yc = merge_branches(pc, attn_c, w_short_conv[l], w_branch_attn[l], w_branch_conv[l], w_out[l])
            ctx_mid = ctx + cgt1 * rmsnorm(yc, g_post_mix[l])
            hc2 = modulate(rmsnorm(ctx_mid, g_pre_ffn[l]), csh2, csc2)
            ctx = ctx_mid + cgt2 * rmsnorm(conv_ffn(hc2, w_up[l], w_ffn_conv[l], b_ffn_conv[l], w_down[l]), g_post_ffn[l])

        h = modulate(rmsnorm(x, g_pre_mix[l]), sh1, sc1)
        p = h @ w_in[l]
        attn = neighbourhood_attention(heads(p[..., Q_OFF:K_OFF]), heads(p[..., K_OFF:V_OFF]),
                                       heads(p[..., V_OFF:BG_OFF]), kc, vc, rpb[l])
        y = merge_branches(p, attn, w_short_conv[l], w_branch_attn[l], w_branch_conv[l], w_out[l])
        x = x + gt1 * rmsnorm(y, g_post_mix[l])

        h = modulate(rmsnorm(x, g_pre_ffn[l]), sh2, sc2)
        x = x + gt2 * rmsnorm(conv_ffn(h, w_up[l], w_ffn_conv[l], b_ffn_conv[l], w_down[l]), g_post_ffn[l])
    return x
```

```cpp
#include <hip/hip_runtime.h>
#include <hip/hip_cooperative_groups.h>
#include <cstdio>
#include <cstdint>
namespace cg = cooperative_groups;

#define LAS __attribute__((address_space(3)))
typedef unsigned short bf16_t;
typedef short bf16x8 __attribute__((ext_vector_type(8)));
typedef float f32x4 __attribute__((ext_vector_type(4)));
typedef unsigned u32x4 __attribute__((ext_vector_type(4)));
typedef unsigned u32x2 __attribute__((ext_vector_type(2)));

constexpr int D = 1024, NB = 16, SEQ = 2048, M = NB * SEQ, CTXL = 256, MC = NB * CTXL, MT = M + MC;
constexpr int INW = 5120, DFF = 2816, UPW = 2 * DFF, ATTW = 512, CONVW = 512;
constexpr int NMOD = 6 * D;
constexpr float EPS = 1e-6f;
constexpr float LOG2E = 1.4426950408889634f;
constexpr int NWAVES = 8, NT = NWAVES * 64;
constexpr int LDS_BYTES = 147456;

constexpr size_t MiB = 1u << 20;
constexpr size_t WS_MOD = 0;
constexpr size_t WS_SS1 = 1 * MiB;
constexpr size_t WS_SS2 = 3 * MiB;
constexpr size_t WS_WIN = 5 * MiB;
constexpr size_t WS_WCAT = 15 * MiB;
constexpr size_t WS_WO = 17 * MiB;
constexpr size_t WS_WUP = 19 * MiB;
constexpr size_t WS_WDN = 30 * MiB;
constexpr size_t WS_A = 36 * MiB;
constexpr size_t WS_P = 108 * MiB;
constexpr size_t WS_U = 36 * MiB;
constexpr size_t WS_B = 428 * MiB;
constexpr size_t WS_VT = WS_B;
constexpr size_t WS_KC = WS_B + 32 * MiB;
constexpr size_t WS_VTC = WS_B + 36 * MiB;
constexpr size_t WS_Z = WS_B;
constexpr size_t WS_H2 = WS_B;
constexpr size_t WS_Y2 = WS_B;
constexpr size_t WS_END = 512 * MiB;

struct Params {
    const float *x, *c, *ctx, *c_ctx, *w_ada, *b_ada, *g_pre_mix, *g_post_mix, *g_pre_ffn, *g_post_ffn, *w_in, *rpb, *w_short_conv,
        *w_branch_attn, *w_branch_conv, *w_out, *w_up, *w_ffn_conv, *b_ffn_conv, *w_down;
    float* out;
    unsigned char* ws;
};

__device__ __forceinline__ unsigned cvt_pk_bf16(float lo, float hi) { unsigned r; asm volatile("v_cvt_pk_bf16_f32 %0, %1, %2" : "=v"(r) : "v"(lo), "v"(hi)); return r; }
__device__ __forceinline__ float bf_lo(unsigned w) { return __builtin_bit_cast(float, w << 16); }
__device__ __forceinline__ float bf_hi(unsigned w) { return __builtin_bit_cast(float, w & 0xffff0000u); }
__device__ __forceinline__ float wave_sum(float v) {
#pragma unroll
    for (int o = 1; o < 64; o <<= 1) v += __shfl_xor(v, o);
    return v;
}
__device__ __forceinline__ float fast_exp2(float x) { return __builtin_amdgcn_exp2f(x); }
__device__ __forceinline__ float fast_rcp(float x) { return __builtin_amdgcn_rcpf(x); }
__device__ __forceinline__ float sigmoidf_(float x) { return fast_rcp(1.0f + fast_exp2(-LOG2E * x)); }
#define LDS_WAIT() asm volatile("s_waitcnt lgkmcnt(0)" ::: "memory")

namespace pg8 {
constexpr int BM = 256, BK = 64, HALF = 128, HTB = HALF * BK * 2, STAGE_BYTES = 8 * HTB, NXCD = 8, WGM = 8;
__host__ __device__ __forceinline__ int lds_byte(int r, int c) { const int st = (r >> 4) * 2 + (c >> 5), rr = r & 15, cc = c & 31, ob = rr * 64 + cc * 2; return st * 1024 + (ob ^ (((ob >> 9) & 1) << 5)); }
__host__ __device__ __forceinline__ void stage_rc(int b, int& R, int& C) { const int st = b / 1024, sb = b % 1024, swz = sb ^ (((sb >> 9) & 1) << 5); R = (st >> 1) * 16 + swz / 64; C = (st & 1) * 32 + (swz % 64) / 2; }
__host__ __device__ __forceinline__ int perm32(int rho) { const int n = rho >> 4, i = rho & 15; return 8 * (i >> 2) + 4 * n + (i & 3); }

struct Unit { int pm, pn; };
struct Gemm { const bf16_t* A; const bf16_t* Bt; int lda, K; };

struct Order {
    int nM, nN, nwg, G, c, extra;
    __device__ void init(int nM_, int nN_, int G_, int c_, int extra_) { nM = nM_; nN = nN_; nwg = nM * nN; G = G_; c = c_; extra = extra_; }
    __device__ bool next(int i, Unit& u) const {
        const long L = (long)i * G + c;
        if (L >= nwg) { const int e = (int)(L - nwg); if (e >= extra) return false; u.pm = nM + (e >> 2); u.pn = 2 + (e & 3); return true; }
        int wgid = (int)L; { const int q = nwg / NXCD, r = nwg % NXCD, xcd = wgid % NXCD, off = wgid / NXCD; wgid = (xcd < r ? xcd * (q + 1) : r * (q + 1) + (xcd - r) * q) + off; }
        const int nig = WGM * nN, gid = wgid / nig, fm = gid * WGM, gsz = (nM - fm) < WGM ? (nM - fm) : WGM;
        u.pm = fm + ((wgid % nig) % gsz); u.pn = (wgid % nig) / gsz; return true;
    }
};

template <class Epi>
__device__ __forceinline__ void gemm_phase(LAS unsigned char* lds, const Gemm g, const Order& S, const Epi& E) {
    const int tid = threadIdx.x, wid = __builtin_amdgcn_readfirstlane(tid >> 6), lane = tid & 63, wr = wid >> 2, wc = wid & 3, fr = lane & 15, fq = lane >> 4;
    const int K = g.K, nt = K / BK, lda = g.lda;
    unsigned voffA[2], voffB[2];
#pragma unroll
    for (int i = 0; i < 2; ++i) { int R, C; stage_rc(tid * 16 + i * 8192, R, C); const int Rb = Epi::PERM ? ((R & ~31) + perm32(R & 31)) : R;
        voffA[i] = (unsigned)(R * lda + C) * 2u; voffB[i] = (unsigned)(Rb * K + C) * 2u; }
    const size_t kstep = (size_t)(BK * 2);
    const size_t hstepA = (size_t)HALF * lda * 2, hstepB = (size_t)HALF * K * 2;
    const size_t tstepA = 2 * hstepA, tstepB = 2 * hstepB;
    const unsigned ldsw = (unsigned)wid * 1024u;
    const int aoff = lds_byte(wr * 64 + fr, fq * 8), boff = lds_byte(wc * 32 + fr, fq * 8);
#define PG8_SA(b, h) (((b) * 2 + (h)) * HTB)
#define PG8_SB(b, h) ((4 + (b) * 2 + (h)) * HTB)
#define PG8_STAGE(bufoff, gbase, voff) do { _Pragma("unroll") for (int _i = 0; _i < 2; ++_i) \
        __builtin_amdgcn_global_load_lds((const unsigned*)((const char*)(gbase) + (voff)[_i]), (LAS unsigned*)(lds + (bufoff) + ldsw + _i * 8192), 16, 0, 0); } while (0)
#define PG8_LDA(dst, b, h) do { _Pragma("unroll") for (int m = 0; m < 4; ++m) _Pragma("unroll") for (int k = 0; k < 2; ++k) dst[m][k] = *(const LAS bf16x8*)(lds + PG8_SA(b, h) + aoff + m * 2048 + k * 1024); } while (0)
#define PG8_LDB(dst, b, h) do { _Pragma("unroll") for (int n = 0; n < 2; ++n) _Pragma("unroll") for (int k = 0; k < 2; ++k) dst[n][k] = *(const LAS bf16x8*)(lds + PG8_SB(b, h) + boff + n * 2048 + k * 1024); } while (0)
#define PG8_MMA(ai, bj, At, Bt) do { __builtin_amdgcn_s_setprio(1); _Pragma("unroll") for (int m = 0; m < 4; ++m) _Pragma("unroll") for (int n = 0; n < 2; ++n) _Pragma("unroll") for (int k = 0; k < 2; ++k) \
        acc[ai][bj][m][n] = __builtin_amdgcn_mfma_f32_16x16x32_bf16(Bt[n][k], At[m][k], acc[ai][bj][m][n], 0, 0, 0); __builtin_amdgcn_s_setprio(0); } while (0)
#define PG8_WAIT_V(n) asm volatile("s_waitcnt vmcnt(" #n ")" ::: "memory")
#define PG8_WAIT_L(n) asm volatile("s_waitcnt lgkmcnt(" #n ")" ::: "memory")
#define PG8_BAR __builtin_amdgcn_s_barrier()
#define PG8_SCHED __builtin_amdgcn_sched_barrier(0)
    Unit cur, nxt; int ui = 0;
    if (!S.next(0, cur)) return;
    f32x4 acc[2][2][4][2];
#pragma unroll
    for (int a = 0; a < 2; ++a)
#pragma unroll
        for (int b = 0; b < 2; ++b)
#pragma unroll
            for (int m = 0; m < 4; ++m)
#pragma unroll
                for (int n = 0; n < 2; ++n) acc[a][b][m][n] = (f32x4){0.f, 0.f, 0.f, 0.f};
    bf16x8 At[4][2], B0[2][2], B1[2][2];
    const char* cA = (const char*)g.A + (size_t)cur.pm * tstepA; const char* cB = (const char*)g.Bt + (size_t)cur.pn * tstepB;
    PG8_STAGE(PG8_SB(0, 0), cB, voffB); PG8_STAGE(PG8_SA(0, 0), cA, voffA); PG8_STAGE(PG8_SB(0, 1), cB + hstepB, voffB); PG8_STAGE(PG8_SA(0, 1), cA + hstepA, voffA);
    if (wr == 1) PG8_BAR;
    PG8_WAIT_V(4); PG8_BAR;
    PG8_STAGE(PG8_SB(1, 0), cB + kstep, voffB); PG8_STAGE(PG8_SA(1, 0), cA + kstep, voffA); PG8_STAGE(PG8_SB(1, 1), cB + hstepB + kstep, voffB);
    PG8_WAIT_V(6); PG8_BAR;
    for (;;) {
        const bool has_next = S.next(ui + 1, nxt);
        const char* nA = has_next ? (const char*)g.A + (size_t)nxt.pm * tstepA : cA; const char* nB = has_next ? (const char*)g.Bt + (size_t)nxt.pn * tstepB : cB;
        for (int th = 0; th < (Epi::MID ? 2 : 1); ++th) {
        const int tb = Epi::MID ? th * Epi::MID_T : 0, te = (Epi::MID && th == 0) ? Epi::MID_T : nt;
        for (int t = tb; t < te; t += 2) {
            const bool last = (t == nt - 2);
            const char* a1 = cA + (size_t)(t + 1) * kstep;
            const char* a2 = last ? nA : cA + (size_t)(t + 2) * kstep; const char* b2 = last ? nB : cB + (size_t)(t + 2) * kstep;
            const char* a3 = a2 + kstep; const char* b3 = b2 + kstep;
            PG8_LDB(B0, 0, 0); PG8_SCHED; PG8_LDA(At, 0, 0); PG8_STAGE(PG8_SA(1, 1), a1 + hstepA, voffA);
            PG8_WAIT_L(8); PG8_BAR; PG8_WAIT_L(0); PG8_MMA(0, 0, At, B0); PG8_BAR; PG8_SCHED;
            PG8_LDB(B1, 0, 1); PG8_STAGE(PG8_SB(0, 0), b2, voffB);
            PG8_BAR; PG8_WAIT_L(0); PG8_MMA(0, 1, At, B1); PG8_BAR;
            PG8_LDA(At, 0, 1); PG8_STAGE(PG8_SA(0, 0), a2, voffA);
            PG8_BAR; PG8_WAIT_L(0); PG8_MMA(1, 0, At, B0); PG8_BAR; PG8_SCHED;
            PG8_STAGE(PG8_SB(0, 1), b2 + hstepB, voffB);
            PG8_WAIT_V(6); PG8_BAR; PG8_MMA(1, 1, At, B1); PG8_BAR;
            PG8_LDB(B0, 1, 0); PG8_SCHED; PG8_LDA(At, 1, 0); PG8_STAGE(PG8_SA(0, 1), a2 + hstepA, voffA);
            PG8_WAIT_L(8); PG8_BAR; PG8_WAIT_L(0); PG8_MMA(0, 0, At, B0); PG8_BAR; PG8_SCHED;
            PG8_LDB(B1, 1, 1); PG8_STAGE(PG8_SB(1, 0), b3, voffB);
            PG8_BAR; PG8_WAIT_L(0); PG8_MMA(0, 1, At, B1); PG8_BAR;
            PG8_LDA(At, 1, 1); PG8_STAGE(PG8_SA(1, 0), a3, voffA);
            PG8_BAR; PG8_WAIT_L(0); PG8_MMA(1, 0, At, B0); PG8_BAR; PG8_SCHED;
            PG8_STAGE(PG8_SB(1, 1), b3 + hstepB, voffB);
            PG8_WAIT_V(6); PG8_BAR; PG8_MMA(1, 1, At, B1); PG8_BAR;
        }
        if constexpr (Epi::MID) { if (th == 0) E.mid(acc, cur, wr, wc, fr, fq); }
        }
        E(acc, cur, wr, wc, fr, fq);
        if (!has_next) break;
#pragma unroll
        for (int a = 0; a < 2; ++a)
#pragma unroll
            for (int b = 0; b < 2; ++b)
#pragma unroll
                for (int m = 0; m < 4; ++m)
#pragma unroll
                    for (int n = 0; n < 2; ++n) acc[a][b][m][n] = (f32x4){0.f, 0.f, 0.f, 0.f};
        cur = nxt; cA = nA; cB = nB; ++ui;
    }
    PG8_WAIT_V(0);
    if (wr == 0) PG8_BAR;
    PG8_BAR;
#undef PG8_SA
#undef PG8_SB
#undef PG8_STAGE
#undef PG8_LDA
#undef PG8_LDB
#undef PG8_MMA
#undef PG8_WAIT_V
#undef PG8_WAIT_L
#undef PG8_BAR
#undef PG8_SCHED
}

typedef f32x4 Acc[2][2][4][2];
__device__ __forceinline__ char* sgpr_launder(const char* p) { char* q = (char*)p; asm volatile("" : "+s"(q)); return q; }
#define GPTR(T, ub, voff) ((T*)(sgpr_launder((const char*)(ub)) + (voff)))
__device__ __forceinline__ u32x4 pack8(const f32x4 v0, const f32x4 v1) { u32x4 w; w.x = cvt_pk_bf16(v0[0], v0[1]); w.y = cvt_pk_bf16(v0[2], v0[3]); w.z = cvt_pk_bf16(v1[0], v1[1]); w.w = cvt_pk_bf16(v1[2], v1[3]); return w; }

struct Epi1 {
    static constexpr bool PERM = true, MID = false; static constexpr int MID_T = 0;
    bf16_t *P, *VT, *Kc, *VTc;
    __device__ __forceinline__ void mid(Acc&, const Unit&, int, int, int, int) const {}
    __device__ __forceinline__ void operator()(const Acc& acc, const Unit& u, int wr, int wc, int fr, int fq) const {
        const bool isctx = u.pm >= (M / BM);
        if (u.pn == 4 || u.pn == 5) {
            if (!isctx) {
                const int row_u = u.pm * BM;
                char* ub = (char*)VT + ((size_t)(row_u >> 11) * 512 * SEQ + (size_t)(u.pn - 4) * 256 * SEQ + (row_u & (SEQ - 1))) * 2;
                const unsigned lo = (unsigned)((wc * 32 + 8 * fq) * SEQ + wr * 64 + fr) * 2u;
#pragma unroll
                for (int ai = 0; ai < 2; ++ai)
#pragma unroll
                    for (int m = 0; m < 4; ++m)
#pragma unroll
                        for (int bj = 0; bj < 2; ++bj)
#pragma unroll
                            for (int n = 0; n < 2; ++n) {
                                const f32x4 v = acc[ai][bj][m][n];
                                const unsigned w0 = cvt_pk_bf16(v[0], v[1]), w1 = cvt_pk_bf16(v[2], v[3]);
                                const int cst = ((bj * HALF + 4 * n) * SEQ + ai * HALF + m * 16) * 2;
                                *GPTR(bf16_t, ub + cst, lo) = (bf16_t)(w0 & 0xffffu); *GPTR(bf16_t, ub + cst + SEQ * 2, lo) = (bf16_t)(w0 >> 16);
                                *GPTR(bf16_t, ub + cst + SEQ * 4, lo) = (bf16_t)(w1 & 0xffffu); *GPTR(bf16_t, ub + cst + SEQ * 6, lo) = (bf16_t)(w1 >> 16);
                            }
            } else {
                const int rc_u = u.pm * BM - M;
                char* ub = (char*)VTc + ((size_t)(rc_u >> 8) * 512 * CTXL + (size_t)(u.pn - 4) * 256 * CTXL) * 2;
                const unsigned lo = (unsigned)((wc * 32 + 8 * fq) * CTXL + wr * 64 + fr) * 2u;
#pragma unroll
                for (int ai = 0; ai < 2; ++ai)
#pragma unroll
                    for (int m = 0; m < 4; ++m)
#pragma unroll
                        for (int bj = 0; bj < 2; ++bj)
#pragma unroll
                            for (int n = 0; n < 2; ++n) {
                                const f32x4 v = acc[ai][bj][m][n];
                                const unsigned w0 = cvt_pk_bf16(v[0], v[1]), w1 = cvt_pk_bf16(v[2], v[3]);
                                const int cst = ((bj * HALF + 4 * n) * CTXL + ai * HALF + m * 16) * 2;
                                *GPTR(bf16_t, ub + cst, lo) = (bf16_t)(w0 & 0xffffu); *GPTR(bf16_t, ub + cst + CTXL * 2, lo) = (bf16_t)(w0 >> 16);
                                *GPTR(bf16_t, ub + cst + CTXL * 4, lo) = (bf16_t)(w1 & 0xffffu); *GPTR(bf16_t, ub + cst + CTXL * 6, lo) = (bf16_t)(w1 >> 16);
                            }
            }
        } else if (isctx) {
            char* ub = (char*)Kc + ((size_t)(u.pm * BM - M) * 512 + (size_t)(u.pn * BM - 512)) * 2;
            const unsigned lo = (unsigned)((wr * 64 + fr) * 512 + wc * 32 + 8 * fq) * 2u;
#pragma unroll
            for (int ai = 0; ai < 2; ++ai)
#pragma unroll
                for (int m = 0; m < 4; ++m)
#pragma unroll
                    for (int bj = 0; bj < 2; ++bj)
                        *GPTR(u32x4, ub + ((ai * HALF + m * 16) * 512 + bj * HALF) * 2, lo) = pack8(acc[ai][bj][m][0], acc[ai][bj][m][1]);
        } else {
            const bool sg = u.pn >= 12;
            char* ub = (char*)P + ((size_t)u.pm * BM * INW + (size_t)u.pn * BM) * 2;
            const unsigned lo = (unsigned)((wr * 64 + fr) * INW + wc * 32 + 8 * fq) * 2u;
#pragma unroll
            for (int ai = 0; ai < 2; ++ai)
#pragma unroll
                for (int m = 0; m < 4; ++m)
#pragma unroll
                    for (int bj = 0; bj < 2; ++bj) { f32x4 v0 = acc[ai][bj][m][0], v1 = acc[ai][bj][m][1];
                        if (sg) {
#pragma unroll
                            for (int j = 0; j < 4; ++j) { v0[j] = sigmoidf_(v0[j]); v1[j] = sigmoidf_(v1[j]); } }
                        *GPTR(u32x4, ub + ((ai * HALF + m * 16) * INW + bj * HALF) * 2, lo) = pack8(v0, v1); }
        }
    }
};

struct Epi2 {
    static constexpr bool PERM = true, MID = true; static constexpr int MID_T = 8;
    const bf16_t* P; bf16_t* Z;
    __device__ __forceinline__ void mid(Acc& acc, const Unit& u, int wr, int wc, int fr, int fq) const {
        const char* ub = (const char*)P + ((size_t)u.pm * BM * INW + (size_t)u.pn * BM) * 2;
        const unsigned lo = (unsigned)((wr * 64 + fr) * INW + wc * 32 + 8 * fq) * 2u;
#pragma unroll
        for (int ai = 0; ai < 2; ++ai)
#pragma unroll
            for (int m = 0; m < 4; ++m) {
#pragma unroll
                for (int bj = 0; bj < 2; ++bj) {
                    const int cst = ((ai * HALF + m * 16) * INW + bj * HALF) * 2;
                    const u32x4 a = *GPTR(const u32x4, ub + cst + 3072 * 2, lo), b = *GPTR(const u32x4, ub + cst + 4096 * 2, lo);
                    f32x4 r0, r1;
                    r0[0] = bf_lo(a.x) * fast_rcp(bf_lo(b.x)); r0[1] = bf_hi(a.x) * fast_rcp(bf_hi(b.x)); r0[2] = bf_lo(a.y) * fast_rcp(bf_lo(b.y)); r0[3] = bf_hi(a.y) * fast_rcp(bf_hi(b.y));
                    r1[0] = bf_lo(a.z) * fast_rcp(bf_lo(b.z)); r1[1] = bf_hi(a.z) * fast_rcp(bf_hi(b.z)); r1[2] = bf_lo(a.w) * fast_rcp(bf_lo(b.w)); r1[3] = bf_hi(a.w) * fast_rcp(bf_hi(b.w));
                    acc[ai][bj][m][0] *= r0; acc[ai][bj][m][1] *= r1;
                }
                if (m & 1) __builtin_amdgcn_sched_barrier(0);
            }
    }
    __device__ __forceinline__ void operator()(const Acc& acc, const Unit& u, int wr, int wc, int fr, int fq) const {
        const char* ub = (const char*)P + ((size_t)u.pm * BM * INW + (size_t)u.pn * BM + 4096) * 2;
        const unsigned lo = (unsigned)((wr * 64 + fr) * INW + wc * 32 + 8 * fq) * 2u;
        char* zb = (char*)Z + ((size_t)u.pm * BM * D + (size_t)u.pn * BM) * 2;
        const unsigned zlo = (unsigned)((wr * 64 + fr) * D + wc * 32 + 8 * fq) * 2u;
#pragma unroll
        for (int ai = 0; ai < 2; ++ai)
#pragma unroll
            for (int m = 0; m < 4; ++m) {
#pragma unroll
                for (int bj = 0; bj < 2; ++bj) {
                    const u32x4 b = *GPTR(const u32x4, ub + ((ai * HALF + m * 16) * INW + bj * HALF) * 2, lo);
                    const f32x4 v0 = acc[ai][bj][m][0], v1 = acc[ai][bj][m][1];
                    u32x4 w; w.x = cvt_pk_bf16(v0[0] * bf_lo(b.x), v0[1] * bf_hi(b.x)); w.y = cvt_pk_bf16(v0[2] * bf_lo(b.y), v0[3] * bf_hi(b.y));
                    w.z = cvt_pk_bf16(v1[0] * bf_lo(b.z), v1[1] * bf_hi(b.z)); w.w = cvt_pk_bf16(v1[2] * bf_lo(b.w), v1[3] * bf_hi(b.w));
                    *GPTR(u32x4, zb + ((ai * HALF + m * 16) * D + bj * HALF) * 2, zlo) = w;
                }
                if (m & 1) __builtin_amdgcn_sched_barrier(0);
            }
    }
};

template <bool SS, int LDC> struct EpiStore {
    static constexpr bool PERM = true, MID = false; static constexpr int MID_T = 0;
    bf16_t* O; float* ssp;
    __device__ __forceinline__ void mid(Acc&, const Unit&, int, int, int, int) const {}
    __device__ __forceinline__ void operator()(const Acc& acc, const Unit& u, int wr, int wc, int fr, int fq) const {
        char* ub = (char*)O + ((size_t)u.pm * BM * LDC + (size_t)u.pn * BM) * 2;
        const unsigned lo = (unsigned)((wr * 64 + fr) * LDC + wc * 32 + 8 * fq) * 2u;
        char* sb = (char*)ssp + ((size_t)u.pm * BM * 16 + (size_t)u.pn * 4) * 4;
        const unsigned slo = (unsigned)((wr * 64 + fr) * 16 + wc) * 4u;
#pragma unroll
        for (int ai = 0; ai < 2; ++ai)
#pragma unroll
            for (int m = 0; m < 4; ++m) {
                float s = 0.f;
#pragma unroll
                for (int bj = 0; bj < 2; ++bj) { const f32x4 v0 = acc[ai][bj][m][0], v1 = acc[ai][bj][m][1];
                    if (SS) s += (v0[0] * v0[0] + v0[1] * v0[1]) + (v0[2] * v0[2] + v0[3] * v0[3]) + (v1[0] * v1[0] + v1[1] * v1[1]) + (v1[2] * v1[2] + v1[3] * v1[3]);
                    *GPTR(u32x4, ub + ((ai * HALF + m * 16) * LDC + bj * HALF) * 2, lo) = pack8(v0, v1); }
                if (SS) { s += __shfl_xor(s, 16); s += __shfl_xor(s, 32); if (fq == 0) *GPTR(float, sb + (ai * HALF + m * 16) * 16 * 4, slo) = s; }
            }
    }
};
}

__device__ __forceinline__ void p0_transpose_item(const float* W, int N, bf16_t* WT, int ldt, int koff, int qlim, float qscale, LAS float* scr, int item, int lane) {
    const int nblk = N / 32, kb = item / nblk, nb = item % nblk, k0 = 64 * kb, n0 = 32 * nb;
#pragma unroll 8
    for (int i = 0; i < 32; ++i) { const int kk = 2 * i + (lane >> 5); scr[kk * 33 + (lane & 31)] = W[(size_t)(k0 + kk) * N + n0 + (lane & 31)]; }
    LDS_WAIT(); asm volatile("" ::: "memory");
    const int c = lane & 7;
#pragma unroll
    for (int j = 0; j < 4; ++j) { const int n = (lane >> 3) + 8 * j; const LAS float* s = scr + (8 * c) * 33 + n;
        const float sc = (n0 + n) < qlim ? qscale : 1.0f;
        u32x4 o; o.x = cvt_pk_bf16(s[0 * 33] * sc, s[1 * 33] * sc); o.y = cvt_pk_bf16(s[2 * 33] * sc, s[3 * 33] * sc); o.z = cvt_pk_bf16(s[4 * 33] * sc, s[5 * 33] * sc); o.w = cvt_pk_bf16(s[6 * 33] * sc, s[7 * 33] * sc);
        *(u32x4*)(WT + (size_t)(n0 + n) * ldt + koff + k0 + 8 * c) = o; }
    LDS_WAIT(); asm volatile("" ::: "memory");
}

__device__ __forceinline__ void phase0(const Params& p, LAS unsigned char* lds, int gw, int NGW, int wave, int lane) {
    unsigned char* ws = p.ws;
    LAS float* sl = (LAS float*)lds;
    for (int i = threadIdx.x; i < 17 * D; i += NT) { const float v = i < 16 * D ? p.c[i] : p.c_ctx[i - 16 * D]; sl[i] = v * sigmoidf_(v); }
    __syncthreads();
    {
        const int nit = NMOD / 16;
        float* mod = (float*)(ws + WS_MOD);
        for (int it = (wave < 2 ? (int)blockIdx.x + wave * (int)gridDim.x : nit); it < nit; it += 2 * gridDim.x) {
            const int kg = lane >> 2, cq = lane & 3, col = it * 16 + cq * 4;
            f32x4 a[17];
#pragma unroll
            for (int b = 0; b < 17; ++b) a[b] = (f32x4){0.f, 0.f, 0.f, 0.f};
#pragma unroll 4
            for (int i = 0; i < 64; ++i) {
                const int k = i * 16 + kg;
                const f32x4 w = *(const f32x4*)(p.w_ada + (size_t)k * NMOD + col);
#pragma unroll
                for (int b = 0; b < 17; ++b) { const float s = sl[b * D + k]; a[b] += w * s; }
            }
#pragma unroll
            for (int b = 0; b < 17; ++b)
#pragma unroll
                for (int e = 0; e < 4; ++e) { float v = a[b][e]; v += __shfl_xor(v, 4); v += __shfl_xor(v, 8); v += __shfl_xor(v, 16); v += __shfl_xor(v, 32); a[b][e] = v; }
            if (kg == 0) { const f32x4 bb = *(const f32x4*)(p.b_ada + col);
#pragma unroll
                for (int b = 0; b < 17; ++b) *(f32x4*)(mod + (size_t)b * NMOD + col) = a[b] + bb; }
        }
    }
    LAS float* scr = (LAS float*)(lds + 17 * D * 4 + wave * 8448);
    constexpr int I_IN = (D / 64) * (INW / 32), I_BA = (ATTW / 64) * (D / 32), I_BB = (CONVW / 64) * (D / 32), I_O = (D / 64) * (D / 32), I_UP = (D / 64) * (UPW / 32), I_DN = (DFF / 64) * (D / 32);
    constexpr int NITEMS = I_IN + I_BA + I_BB + I_O + I_UP + I_DN;
    for (int it = gw; it < NITEMS; it += NGW) {
        int r = it;
        if (r < I_IN) { p0_transpose_item(p.w_in, INW, (bf16_t*)(ws + WS_WIN), D, 0, 512, 0.125f * LOG2E, scr, r, lane); continue; } r -= I_IN;
        if (r < I_BA) { p0_transpose_item(p.w_branch_attn, D, (bf16_t*)(ws + WS_WCAT), D, 0, 0, 1.f, scr, r, lane); continue; } r -= I_BA;
        if (r < I_BB) { p0_transpose_item(p.w_branch_conv, D, (bf16_t*)(ws + WS_WCAT), D, 512, 0, 1.f, scr, r, lane); continue; } r -= I_BB;
        if (r < I_O) { p0_transpose_item(p.w_out, D, (bf16_t*)(ws + WS_WO), D, 0, 0, 1.f, scr, r, lane); continue; } r -= I_O;
        if (r < I_UP) { p0_transpose_item(p.w_up, UPW, (bf16_t*)(ws + WS_WUP), D, 0, 0, 1.f, scr, r, lane); continue; } r -= I_UP;
        p0_transpose_item(p.w_down, D, (bf16_t*)(ws + WS_WDN), DFF, 0, 0, 1.f, scr, r, lane);
    }
}

__device__ __forceinline__ void phase1(const Params& p, int gw, int NGW, int lane) {
    const float* mod = (const float*)(p.ws + WS_MOD);
    bf16_t* H = (bf16_t*)(p.ws + WS_A);
    for (int row = gw; row < MT; row += NGW) {
        const float* xr = row < M ? p.x + (size_t)row * D : p.ctx + (size_t)(row - M) * D;
        const int b = row < M ? (row >> 11) : 16;
        const float* md = mod + (size_t)b * NMOD;
        f32x4 v[4]; float s = 0.f;
#pragma unroll
        for (int j = 0; j < 4; ++j) { v[j] = *(const f32x4*)(xr + 4 * lane + 256 * j); s += (v[j][0] * v[j][0] + v[j][1] * v[j][1]) + (v[j][2] * v[j][2] + v[j][3] * v[j][3]); }
        const float rstd = 1.0f / sqrtf(wave_sum(s) * (1.0f / D) + EPS);
#pragma unroll
        for (int j = 0; j < 4; ++j) {
            const int col = 4 * lane + 256 * j;
            const f32x4 g = *(const f32x4*)(p.g_pre_mix + col), sh = *(const f32x4*)(md + col), sc = *(const f32x4*)(md + D + col);
            f32x4 h = (v[j] * rstd) * g; h = h * (sc + 1.0f) + sh;
            u32x2 o; o.x = cvt_pk_bf16(h[0], h[1]); o.y = cvt_pk_bf16(h[2], h[3]);
            *(u32x2*)(H + (size_t)row * D + col) = o;
        }
    }
}

struct KV { bf16x8 k[2][2]; bf16x8 v[4]; };

__device__ __forceinline__ void attn_load(KV& f, int c, int nwin, int rlo, int b, int h, int kstart, int fr, int fq,
                                          const bf16_t* P, const bf16_t* VT, const bf16_t* Kc, const bf16_t* VTc) {
    const bf16_t* kb; const bf16_t* vb; int kld, vld;
    if (c < nwin) { const int rr = rlo + c; kb = P + (size_t)(b * SEQ + rr * 64 + kstart) * INW + 512 + 64 * h; kld = INW; vb = VT + (size_t)(b * 512 + 64 * h) * SEQ + rr * 64 + kstart; vld = SEQ; }
    else { const int cc = c - nwin; kb = Kc + (size_t)(b * CTXL + cc * 32) * 512 + 64 * h; kld = 512; vb = VTc + (size_t)(b * 512 + 64 * h) * CTXL + cc * 32; vld = CTXL; }
    const int kr = 8 * (fr >> 2) + (fr & 3);
#pragma unroll
    for (int blk = 0; blk < 2; ++blk)
#pragma unroll
        for (int ds = 0; ds < 2; ++ds) f.k[blk][ds] = *(const bf16x8*)(kb + (size_t)(kr + 4 * blk) * kld + 32 * ds + 8 * fq);
#pragma unroll
    for (int db = 0; db < 4; ++db) f.v[db] = *(const bf16x8*)(vb + (size_t)(16 * db + fr) * vld + 8 * fq);
}

__device__ __forceinline__ void phase3(const Params& p, LAS unsigned char* lds, int gw, int NGW, int lane) {
    const bf16_t* P = (const bf16_t*)(p.ws + WS_P); const bf16_t* VT = (const bf16_t*)(p.ws + WS_VT);
    const bf16_t* Kc = (const bf16_t*)(p.ws + WS_KC); const bf16_t* VTc = (const bf16_t*)(p.ws + WS_VTC);
    bf16_t* ATT = (bf16_t*)(p.ws + WS_A);
    constexpr int TPAD = 32, NRPB = 8 * 15 * 31;
    LAS float* tab = (LAS float*)lds;
    for (int i = threadIdx.x; i < NRPB + 2 * TPAD + 64; i += NT) { const int j = i - TPAD; tab[i] = (j >= 0 && j < NRPB) ? p.rpb[j] * LOG2E : 0.f; }
    __syncthreads();
    const int fr = lane & 15, fq = lane >> 4;
    for (int item = gw; item < 4096; item += NGW) {
        const int rg = item & 7, n = (item >> 3) & 3, h = (item >> 5) & 7, b = item >> 8;
        const int r0 = rg * 4;
        const int kstart = n == 0 ? 0 : (n == 1 ? 8 : (n == 2 ? 24 : 32));
        const int qcol = 16 * n + fr;
        const int cs = min(max(qcol - 8, 0), 48);
        unsigned vmask = 0;
#pragma unroll
        for (int j = 0; j < 8; ++j) { const int kc = kstart + 8 * fq + j; if (kc >= cs && kc < cs + 16) vmask |= 1u << j; }
        const int dc0 = kstart + 8 * fq - qcol + 15;
        const int rlo = min(max(r0 - 4, 0), 24), rhi = min(max(r0 + 3 - 4, 0), 24) + 7;
        const int nwin = rhi - rlo + 1, nch = nwin + 8;
        bf16x8 qf[4][2];
#pragma unroll
        for (int qi = 0; qi < 4; ++qi)
#pragma unroll
            for (int ds = 0; ds < 2; ++ds) qf[qi][ds] = *(const bf16x8*)(P + (size_t)(b * SEQ + (r0 + qi) * 64 + qcol) * INW + 64 * h + 32 * ds + 8 * fq);
        f32x4 o[4][4]; float mrun[4], lrun[4];
#pragma unroll
        for (int qi = 0; qi < 4; ++qi) { mrun[qi] = -1e30f; lrun[qi] = 0.f;
#pragma unroll
            for (int db = 0; db < 4; ++db) o[qi][db] = (f32x4){0.f, 0.f, 0.f, 0.f}; }
        KV cur, nxt;
        attn_load(cur, 0, nwin, rlo, b, h, kstart, fr, fq, P, VT, Kc, VTc);
        for (int c = 0; c < nch; ++c) {
            if (c + 1 < nch) attn_load(nxt, c + 1, nwin, rlo, b, h, kstart, fr, fq, P, VT, Kc, VTc);
            const bool win = c < nwin; const int rr = rlo + c;
#pragma unroll
            for (int qi = 0; qi < 4; ++qi) {
                const int r = r0 + qi, rs = min(max(r - 4, 0), 24);
                if (win && (rr < rs || rr > rs + 7)) continue;
                f32x4 s0 = (f32x4){0.f, 0.f, 0.f, 0.f}, s1 = (f32x4){0.f, 0.f, 0.f, 0.f};
                s0 = __builtin_amdgcn_mfma_f32_16x16x32_bf16(cur.k[0][0], qf[qi][0], s0, 0, 0, 0);
                s0 = __builtin_amdgcn_mfma_f32_16x16x32_bf16(cur.k[0][1], qf[qi][1], s0, 0, 0, 0);
                s1 = __builtin_amdgcn_mfma_f32_16x16x32_bf16(cur.k[1][0], qf[qi][0], s1, 0, 0, 0);
                s1 = __builtin_amdgcn_mfma_f32_16x16x32_bf16(cur.k[1][1], qf[qi][1], s1, 0, 0, 0);
                float sv[8] = {s0[0], s0[1], s0[2], s0[3], s1[0], s1[1], s1[2], s1[3]};
                if (win) {
                    const LAS float* bp = tab + TPAD + h * 465 + (rr - r + 7) * 31 + dc0;
#pragma unroll
                    for (int j = 0; j < 8; ++j) sv[j] = ((vmask >> j) & 1u) ? sv[j] + bp[j] : -1e30f;
                }
                float mx = fmaxf(fmaxf(fmaxf(sv[0], sv[1]), fmaxf(sv[2], sv[3])), fmaxf(fmaxf(sv[4], sv[5]), fmaxf(sv[6], sv[7])));
                mx = fmaxf(mx, __shfl_xor(mx, 16)); mx = fmaxf(mx, __shfl_xor(mx, 32));
                const float mn = fmaxf(mrun[qi], mx), alpha = fast_exp2(mrun[qi] - mn);
                mrun[qi] = mn;
                float ps = 0.f;
#pragma unroll
                for (int j = 0; j < 8; ++j) { sv[j] = fast_exp2(sv[j] - mn); ps += sv[j]; }
                lrun[qi] = lrun[qi] * alpha + ps;
                union { bf16x8 v; unsigned w[4]; } pf;
                pf.w[0] = cvt_pk_bf16(sv[0], sv[1]); pf.w[1] = cvt_pk_bf16(sv[2], sv[3]); pf.w[2] = cvt_pk_bf16(sv[4], sv[5]); pf.w[3] = cvt_pk_bf16(sv[6], sv[7]);
#pragma unroll
                for (int db = 0; db < 4; ++db) { o[qi][db] *= alpha; o[qi][db] = __builtin_amdgcn_mfma_f32_16x16x32_bf16(cur.v[db], pf.v, o[qi][db], 0, 0, 0); }
            }
            cur = nxt;
        }
#pragma unroll
        for (int qi = 0; qi < 4; ++qi) {
            float l = lrun[qi]; l += __shfl_xor(l, 16); l += __shfl_xor(l, 32);
            const float inv = 1.0f / l;
            bf16_t* op = ATT + (size_t)(b * SEQ + (r0 + qi) * 64 + qcol) * D + 64 * h + 4 * fq;
#pragma unroll
            for (int db = 0; db < 4; ++db) { const f32x4 v = o[qi][db] * inv; u32x2 w; w.x = cvt_pk_bf16(v[0], v[1]); w.y = cvt_pk_bf16(v[2], v[3]); *(u32x2*)(op + 16 * db) = w; }
        }
    }
    {
        const int c8 = lane * 8;
        float w0[8], w1[8], w2[8];
#pragma unroll
        for (int e = 0; e < 8; ++e) { w0[e] = p.w_short_conv[c8 + e]; w1[e] = p.w_short_conv[CONVW + c8 + e]; w2[e] = p.w_short_conv[2 * CONVW + c8 + e]; }
        for (int tok = gw; tok < M; tok += NGW) {
            const int t = tok & (SEQ - 1);
            const bf16_t* rp = P + (size_t)tok * INW;
            const u32x4 z4 = (u32x4){0u, 0u, 0u, 0u};
            const u32x4 bg = *(const u32x4*)(rp + 1536 + c8);
            const u32x4 c1 = *(const u32x4*)(rp + 2048 + c8), h1 = *(const u32x4*)(rp + 2560 + c8);
            const u32x4 c0 = t > 0 ? *(const u32x4*)(rp - INW + 2048 + c8) : z4, h0 = t > 0 ? *(const u32x4*)(rp - INW + 2560 + c8) : z4;
            const u32x4 c2 = t < SEQ - 1 ? *(const u32x4*)(rp + INW + 2048 + c8) : z4, h2 = t < SEQ - 1 ? *(const u32x4*)(rp + INW + 2560 + c8) : z4;
            u32x4 o;
#pragma unroll
            for (int q = 0; q < 4; ++q) {
                const float lo = bf_lo(bg[q]) * (w0[2 * q] * (bf_lo(c0[q]) * bf_lo(h0[q])) + w1[2 * q] * (bf_lo(c1[q]) * bf_lo(h1[q])) + w2[2 * q] * (bf_lo(c2[q]) * bf_lo(h2[q])));
                const float hi = bf_hi(bg[q]) * (w0[2 * q + 1] * (bf_hi(c0[q]) * bf_hi(h0[q])) + w1[2 * q + 1] * (bf_hi(c1[q]) * bf_hi(h1[q])) + w2[2 * q + 1] * (bf_hi(c2[q]) * bf_hi(h2[q])));
                o[q] = cvt_pk_bf16(lo, hi);
            }
            *(u32x4*)(ATT + (size_t)tok * D + 512 + c8) = o;
        }
    }
}

__device__ __forceinline__ void phase6(const Params& p, int gw, int NGW, int lane) {
    const float* mod = (const float*)(p.ws + WS_MOD);
    const bf16_t* Y = (const bf16_t*)(p.ws + WS_A);
    const float* ss1 = (const float*)(p.ws + WS_SS1);
    bf16_t* H2 = (bf16_t*)(p.ws + WS_H2);
    for (int row = gw; row < M; row += NGW) {
        const float* md = mod + (size_t)(row >> 11) * NMOD;
        float ps = ss1[(size_t)row * 16 + (lane & 15)];
        ps += __shfl_xor(ps, 1); ps += __shfl_xor(ps, 2); ps += __shfl_xor(ps, 4); ps += __shfl_xor(ps, 8);
        const float rstdy = 1.0f / sqrtf(ps * (1.0f / D) + EPS);
        f32x4 v[4]; float s = 0.f;
#pragma unroll
        for (int j = 0; j < 4; ++j) {
            const int col = 4 * lane + 256 * j;
            const f32x4 xv = *(const f32x4*)(p.x + (size_t)row * D + col);
            const u32x2 yw = *(const u32x2*)(Y + (size_t)row * D + col);
            const f32x4 y = (f32x4){bf_lo(yw.x), bf_hi(yw.x), bf_lo(yw.y), bf_hi(yw.y)};
            const f32x4 g = *(const f32x4*)(p.g_post_mix + col), gt = *(const f32x4*)(md + 2 * D + col);
            v[j] = xv + gt * ((y * rstdy) * g);
            *(f32x4*)(p.out + (size_t)row * D + col) = v[j];
            s += (v[j][0] * v[j][0] + v[j][1] * v[j][1]) + (v[j][2] * v[j][2] + v[j][3] * v[j][3]);
        }
        const float rstd = 1.0f / sqrtf(wave_sum(s) * (1.0f / D) + EPS);
#pragma unroll
        for (int j = 0; j < 4; ++j) {
            const int col = 4 * lane + 256 * j;
            const f32x4 g = *(const f32x4*)(p.g_pre_ffn + col), sh = *(const f32x4*)(md + 3 * D + col), sc = *(const f32x4*)(md + 4 * D + col);
            f32x4 h = (v[j] * rstd) * g; h = h * (sc + 1.0f) + sh;
            u32x2 o; o.x = cvt_pk_bf16(h[0], h[1]); o.y = cvt_pk_bf16(h[2], h[3]);
            *(u32x2*)(H2 + (size_t)row * D + col) = o;
        }
    }
}

__device__ __forceinline__ float gelu_tanh_(float v) {
    const float u = 1.5957691216057308f * (v + 0.044715f * v * v * v);
    return v * fast_rcp(1.0f + fast_exp2(-LOG2E * u));
}
__device__ __forceinline__ void phase8(const Params& p, int gtid, int NGT) {
    bf16_t* U = (bf16_t*)(p.ws + WS_U);
    constexpr int CPT = DFF / 8;
    for (int idx = gtid; idx < M * CPT; idx += NGT) {
        const int tok = idx / CPT, c8 = (idx - tok * CPT) * 8, t = tok & (SEQ - 1);
        bf16_t* rp = U + (size_t)tok * UPW;
        const u32x4 z4 = (u32x4){0u, 0u, 0u, 0u};
        const u32x4 a = *(const u32x4*)(rp + c8);
        const u32x4 g1 = *(const u32x4*)(rp + DFF + c8);
        const u32x4 g0 = t > 0 ? *(const u32x4*)(rp - UPW + DFF + c8) : z4;
        const u32x4 g2 = t < SEQ - 1 ? *(const u32x4*)(rp + UPW + DFF + c8) : z4;
        const f32x4 w0a = *(const f32x4*)(p.w_ffn_conv + c8), w0b = *(const f32x4*)(p.w_ffn_conv + c8 + 4);
        const f32x4 w1a = *(const f32x4*)(p.w_ffn_conv + DFF + c8), w1b = *(const f32x4*)(p.w_ffn_conv + DFF + c8 + 4);
        const f32x4 w2a = *(const f32x4*)(p.w_ffn_conv + 2 * DFF + c8), w2b = *(const f32x4*)(p.w_ffn_conv + 2 * DFF + c8 + 4);
        const f32x4 ba = *(const f32x4*)(p.b_ffn_conv + c8), bb = *(const f32x4*)(p.b_ffn_conv + c8 + 4);
        const float w0[8] = {w0a[0], w0a[1], w0a[2], w0a[3], w0b[0], w0b[1], w0b[2], w0b[3]};
        const float w1[8] = {w1a[0], w1a[1], w1a[2], w1a[3], w1b[0], w1b[1], w1b[2], w1b[3]};
        const float w2[8] = {w2a[0], w2a[1], w2a[2], w2a[3], w2b[0], w2b[1], w2b[2], w2b[3]};
        const float bc[8] = {ba[0], ba[1], ba[2], ba[3], bb[0], bb[1], bb[2], bb[3]};
        u32x4 o;
#pragma unroll
        for (int q = 0; q < 4; ++q) {
            const float lo = gelu_tanh_(w0[2 * q] * bf_lo(g0[q]) + w1[2 * q] * bf_lo(g1[q]) + w2[2 * q] * bf_lo(g2[q]) + bc[2 * q]) * bf_lo(a[q]);
            const float hi = gelu_tanh_(w0[2 * q + 1] * bf_hi(g0[q]) + w1[2 * q + 1] * bf_hi(g1[q]) + w2[2 * q + 1] * bf_hi(g2[q]) + bc[2 * q + 1]) * bf_hi(a[q]);
            o[q] = cvt_pk_bf16(lo, hi);
        }
        *(u32x4*)(rp + c8) = o;
    }
}

__device__ __forceinline__ void phase10(const Params& p, int gw, int NGW, int lane) {
    const float* mod = (const float*)(p.ws + WS_MOD);
    const bf16_t* Y2 = (const bf16_t*)(p.ws + WS_Y2);
    const float* ss2 = (const float*)(p.ws + WS_SS2);
    for (int row = gw; row < M; row += NGW) {
        const float* md = mod + (size_t)(row >> 11) * NMOD;
        float ps = ss2[(size_t)row * 16 + (lane & 15)];
        ps += __shfl_xor(ps, 1); ps += __shfl_xor(ps, 2); ps += __shfl_xor(ps, 4); ps += __shfl_xor(ps, 8);
        const float rstdy = 1.0f / sqrtf(ps * (1.0f / D) + EPS);
#pragma unroll
        for (int j = 0; j < 4; ++j) {
            const int col = 4 * lane + 256 * j;
            const f32x4 xv = *(const f32x4*)(p.out + (size_t)row * D + col);
            const u32x2 yw = *(const u32x2*)(Y2 + (size_t)row * D + col);
            const f32x4 y = (f32x4){bf_lo(yw.x), bf_hi(yw.x), bf_lo(yw.y), bf_hi(yw.y)};
            const f32x4 g = *(const f32x4*)(p.g_post_ffn + col), gt = *(const f32x4*)(md + 5 * D + col);
            *(f32x4*)(p.out + (size_t)row * D + col) = xv + gt * ((y * rstdy) * g);
        }
    }
}

__global__ void __launch_bounds__(NT, 2) mk_fwd(Params p) {
    extern __shared__ __attribute__((aligned(16))) unsigned char lds_raw[];
    LAS unsigned char* lds = (LAS unsigned char*)lds_raw;
    cg::grid_group grid = cg::this_grid();
    const int tid = threadIdx.x, lane = tid & 63, wave = __builtin_amdgcn_readfirstlane(tid >> 6);
    const int G = gridDim.x, gw = blockIdx.x * NWAVES + wave, NGW = G * NWAVES;
    unsigned char* ws = p.ws;

#ifndef NO_P0
    phase0(p, lds, gw, NGW, wave, lane);
#endif
    grid.sync();
#ifndef NO_P1
    phase1(p, gw, NGW, lane);
#endif
    grid.sync();
    {
        pg8::Gemm g{(const bf16_t*)(ws + WS_A), (const bf16_t*)(ws + WS_WIN), D, D};
        pg8::Order S; S.init(M / 256, INW / 256, G, (int)blockIdx.x, (MC / 256) * 4);
        pg8::Epi1 E{(bf16_t*)(ws + WS_P), (bf16_t*)(ws + WS_VT), (bf16_t*)(ws + WS_KC), (bf16_t*)(ws + WS_VTC)};
#ifndef NO_G1
        pg8::gemm_phase<pg8::Epi1>(lds, g, S, E);
#endif
    }
    grid.sync();
#ifndef NO_P3
    phase3(p, lds, gw, NGW, lane);
#endif
    grid.sync();
    {
        pg8::Gemm g{(const bf16_t*)(ws + WS_A), (const bf16_t*)(ws + WS_WCAT), D, D};
        pg8::Order S; S.init(M / 256, D / 256, G, (int)blockIdx.x, 0);
        pg8::Epi2 E{(const bf16_t*)(ws + WS_P), (bf16_t*)(ws + WS_Z)};
#ifndef NO_G2
        pg8::gemm_phase<pg8::Epi2>(lds, g, S, E);
#endif
    }
    grid.sync();
    {
        pg8::Gemm g{(const bf16_t*)(ws + WS_Z), (const bf16_t*)(ws + WS_WO), D, D};
        pg8::Order S; S.init(M / 256, D / 256, G, (int)blockIdx.x, 0);
        pg8::EpiStore<true, D> E{(bf16_t*)(ws + WS_A), (float*)(ws + WS_SS1)};
#ifndef NO_G3
        pg8::gemm_phase<pg8::EpiStore<true, D>>(lds, g, S, E);
#endif
    }
    grid.sync();
#ifndef NO_P6
    phase6(p, gw, NGW, lane);
#endif
    grid.sync();
    {
        pg8::Gemm g{(const bf16_t*)(ws + WS_H2), (const bf16_t*)(ws + WS_WUP), D, D};
        pg8::Order S; S.init(M / 256, UPW / 256, G, (int)blockIdx.x, 0);
        pg8::EpiStore<false, UPW> E{(bf16_t*)(ws + WS_U), nullptr};
#ifndef NO_G4
        pg8::gemm_phase<pg8::EpiStore<false, UPW>>(lds, g, S, E);
#endif
    }
    grid.sync();
#ifndef NO_P8
    phase8(p, blockIdx.x * NT + tid, G * NT);
#endif
    grid.sync();
    {
        pg8::Gemm g{(const bf16_t*)(ws + WS_U), (const bf16_t*)(ws + WS_WDN), UPW, DFF};
        pg8::Order S; S.init(M / 256, D / 256, G, (int)blockIdx.x, 0);
        pg8::EpiStore<true, D> E{(bf16_t*)(ws + WS_Y2), (float*)(ws + WS_SS2)};
#ifndef NO_G3
        pg8::gemm_phase<pg8::EpiStore<true, D>>(lds, g, S, E);
#endif
    }
    grid.sync();
    phase10(p, gw, NGW, lane);
}

extern "C" void kernel_launch(void* const* d_in, const int* in_sizes, int n_in, void* d_out, int out_size, void* d_ws, size_t ws_size, hipStream_t stream) {
    static int grid = 0;
    if (grid == 0) {
        if (n_in != 20 || in_sizes[0] != M * D || out_size != M * D || ws_size < WS_END) {
            fprintf(stderr, "kernel_launch: unexpected shapes (n_in %d, in0 %d, out %d, ws %zu; need ws >= %zu); nothing launched\n", n_in, n_in > 0 ? in_sizes[0] : -1, out_size, ws_size, (size_t)WS_END);
            grid = -1; return; }
        int dev = 0, cus = 0, per_cu = 0;
        hipGetDevice(&dev);
        hipDeviceGetAttribute(&cus, hipDeviceAttributeMultiprocessorCount, dev);
        if (hipFuncSetAttribute((const void*)mk_fwd, hipFuncAttributeMaxDynamicSharedMemorySize, LDS_BYTES) != hipSuccess) { fprintf(stderr, "kernel_launch: hipFuncSetAttribute failed\n"); grid = -1; return; }
        if (hipOccupancyMaxActiveBlocksPerMultiprocessor(&per_cu, (const void*)mk_fwd, NT, LDS_BYTES) != hipSuccess || per_cu < 1) { fprintf(stderr, "kernel_launch: occupancy query says %d\n", per_cu); per_cu = 1; }
        (void)hipGetLastError();
        grid = cus * per_cu;
    }
    if (grid < 0) return;
    Params p{};
    p.x = (const float*)d_in[0]; p.c = (const float*)d_in[1]; p.ctx = (const float*)d_in[2]; p.c_ctx = (const float*)d_in[3];
    p.w_ada = (const float*)d_in[4]; p.b_ada = (const float*)d_in[5]; p.g_pre_mix = (const float*)d_in[6]; p.g_post_mix = (const float*)d_in[7];
    p.g_pre_ffn = (const float*)d_in[8]; p.g_post_ffn = (const float*)d_in[9]; p.w_in = (const float*)d_in[10]; p.rpb = (const float*)d_in[11];
    p.w_short_conv = (const float*)d_in[12]; p.w_branch_attn = (const float*)d_in[13]; p.w_branch_conv = (const float*)d_in[14]; p.w_out = (const float*)d_in[15];
    p.w_up = (const float*)d_in[16]; p.w_ffn_conv = (const float*)d_in[17]; p.b_ffn_conv = (const float*)d_in[18]; p.w_down = (const float*)d_in[19];
    p.out = (float*)d_out; p.ws = (unsigned char*)d_ws;
    void* args[] = {&p};
    hipError_t e = hipLaunchCooperativeKernel((const void*)mk_fwd, dim3(grid), dim3(NT), args, LDS_BYTES, stream);
    if (e != hipSuccess) fprintf(stderr, "kernel_launch: cooperative launch failed: %s (grid %d)\n", hipGetErrorString(e), grid);
}
```

```cpp
#include <hip/hip_runtime.h>
#include <hip/hip_cooperative_groups.h>
#include <cstdio>
#include <cstdint>
namespace cg = cooperative_groups;

#define LAS __attribute__((address_space(3)))
typedef unsigned short bf16_t;
typedef short bf16x8 __attribute__((ext_vector_type(8)));
typedef float f32x4 __attribute__((ext_vector_type(4)));
typedef unsigned u32x4 __attribute__((ext_vector_type(4)));
typedef unsigned u32x2 __attribute__((ext_vector_type(2)));

constexpr int D = 1024, NB = 16, SEQ = 2048, M = NB * SEQ, CTXL = 256, MC = NB * CTXL, MT = M + MC;
constexpr int INW = 5120, DFF = 2816, UPW = 2 * DFF, ATTW = 512, CONVW = 512;
constexpr int NMOD = 6 * D;
constexpr float EPS = 1e-6f;
constexpr float LOG2E = 1.4426950408889634f;
constexpr int NWAVES = 8, NT = NWAVES * 64;
constexpr int LDS_BYTES = 147456;

constexpr size_t MiB = 1u << 20;
constexpr size_t WS_MOD = 0;
constexpr size_t WS_BAR = 512 * 1024;
constexpr size_t WS_SS1 = 1 * MiB;
constexpr size_t WS_SS2 = 3 * MiB;
constexpr size_t WS_WIN = 5 * MiB;
constexpr size_t WS_WCAT = 15 * MiB;
constexpr size_t WS_WO = 17 * MiB;
constexpr size_t WS_WUP = 19 * MiB;
constexpr size_t WS_WDN = 30 * MiB;
constexpr size_t WS_A = 36 * MiB;
constexpr size_t WS_P = 108 * MiB;
constexpr size_t WS_ACT = 108 * MiB;
constexpr size_t WS_SBG = 284 * MiB;
constexpr size_t WS_SBP = 295 * MiB;
constexpr size_t WS_SBA = 306 * MiB;
constexpr size_t WS_B = 428 * MiB;
constexpr size_t WS_VT = WS_B;
constexpr size_t WS_KC = WS_B + 32 * MiB;
constexpr size_t WS_VTC = WS_B + 36 * MiB;
constexpr size_t WS_Z = WS_B;
constexpr size_t WS_H2 = WS_B;
constexpr size_t WS_Y2 = WS_B;
constexpr size_t WS_END = 512 * MiB;

struct Params {
    const float *x, *c, *ctx, *c_ctx, *w_ada, *b_ada, *g_pre_mix, *g_post_mix, *g_pre_ffn, *g_post_ffn, *w_in, *rpb, *w_short_conv,
        *w_branch_attn, *w_branch_conv, *w_out, *w_up, *w_ffn_conv, *b_ffn_conv, *w_down;
    float* out;
    unsigned char* ws;
};

__device__ __forceinline__ unsigned cvt_pk_bf16(float lo, float hi) { unsigned r; asm volatile("v_cvt_pk_bf16_f32 %0, %1, %2" : "=v"(r) : "v"(lo), "v"(hi)); return r; }
__device__ __forceinline__ float bf_lo(unsigned w) { return __builtin_bit_cast(float, w << 16); }
__device__ __forceinline__ float bf_hi(unsigned w) { return __builtin_bit_cast(float, w & 0xffff0000u); }
__device__ __forceinline__ float fast_exp2(float x) { return __builtin_amdgcn_exp2f(x); }
__device__ __forceinline__ float fast_rcp(float x) { return __builtin_amdgcn_rcpf(x); }
__device__ __forceinline__ float sigmoidf_(float x) { return fast_rcp(1.0f + fast_exp2(-LOG2E * x)); }
#define LDS_WAIT() asm volatile("s_waitcnt lgkmcnt(0)" ::: "memory")
__device__ __forceinline__ void swap16(float x, float& a, float& b) { a = x; b = x; asm volatile("s_nop 1\n\tv_permlane16_swap_b32 %0, %1" : "+v"(a), "+v"(b)); }
__device__ __forceinline__ void swap32(float x, float& a, float& b) { a = x; b = x; asm volatile("s_nop 1\n\tv_permlane32_swap_b32 %0, %1" : "+v"(a), "+v"(b)); }
__device__ __forceinline__ float max_x16_x32(float x) { float a, b; swap16(x, a, b); x = fmaxf(a, b); swap32(x, a, b); return fmaxf(a, b); }
__device__ __forceinline__ float sum_x16_x32(float x) { float a, b; swap16(x, a, b); x = a + b; swap32(x, a, b); return a + b; }
template <int CTRL> __device__ __forceinline__ float dpp_f(float v) { return __builtin_bit_cast(float, __builtin_amdgcn_update_dpp(0, __builtin_bit_cast(int, v), CTRL, 0xf, 0xf, false)); }
__device__ __forceinline__ float wave_sum(float v) {
    v += dpp_f<0xB1>(v);
    v += dpp_f<0x4E>(v);
    v += dpp_f<0x124>(v);
    v += dpp_f<0x128>(v);
    return sum_x16_x32(v);
}
__device__ __forceinline__ float row16_sum(float v) { v += dpp_f<0xB1>(v); v += dpp_f<0x4E>(v); v += dpp_f<0x124>(v); v += dpp_f<0x128>(v); return v; }

namespace pg8 {
constexpr int BM = 256, BK = 64, HALF = 128, HTB = HALF * BK * 2, STAGE_BYTES = 8 * HTB, NXCD = 8, WGM = 4;
__host__ __device__ __forceinline__ int lds_byte(int r, int c) { const int st = (r >> 4) * 2 + (c >> 5), rr = r & 15, cc = c & 31, ob = rr * 64 + cc * 2; return st * 1024 + (ob ^ (((ob >> 9) & 1) << 5)); }
__host__ __device__ __forceinline__ void stage_rc(int b, int& R, int& C) { const int st = b / 1024, sb = b % 1024, swz = sb ^ (((sb >> 9) & 1) << 5); R = (st >> 1) * 16 + swz / 64; C = (st & 1) * 32 + (swz % 64) / 2; }
__host__ __device__ __forceinline__ int perm32(int rho) { const int n = rho >> 4, i = rho & 15; return 8 * (i >> 2) + 4 * n + (i & 3); }

struct Unit { int pm, pn; };
struct Gemm { const bf16_t* A; const bf16_t* Bt; int lda, K; };

struct Order {
    int nM, nN, nwg, G, c, extra;
    __device__ void init(int nM_, int nN_, int G_, int c_, int extra_) { nM = nM_; nN = nN_; nwg = nM * nN; G = G_; c = c_; extra = extra_; }
    __device__ bool next(int i, Unit& u) const {
        const long L = (long)i * G + c;
        if (L >= nwg) { const int e = (int)(L - nwg); if (e >= extra) return false; u.pm = nM + (e >> 2); u.pn = 2 + (e & 3); return true; }
        int wgid = (int)L; { const int q = nwg / NXCD, r = nwg % NXCD, xcd = wgid % NXCD, off = wgid / NXCD; wgid = (xcd < r ? xcd * (q + 1) : r * (q + 1) + (xcd - r) * q) + off; }
        const int nig = WGM * nN, gid = wgid / nig, fm = gid * WGM, gsz = (nM - fm) < WGM ? (nM - fm) : WGM;
        u.pm = fm + ((wgid % nig) % gsz); u.pn = (wgid % nig) / gsz; return true;
    }
};

template <class Epi>
__device__ __forceinline__ void gemm_phase(LAS unsigned char* lds, const Gemm g, const Order& S, const Epi& E) {
    int tid = threadIdx.x; asm volatile("" : "+v"(tid));
    const int wid = __builtin_amdgcn_readfirstlane(tid >> 6), lane = tid & 63, wr = wid >> 2, wc = wid & 3, fr = lane & 15, fq = lane >> 4;
    const int K = g.K, nt = K / BK, lda = g.lda;
    unsigned voffA[2], voffB[2];
#pragma unroll
    for (int i = 0; i < 2; ++i) { int R, C; stage_rc(tid * 16 + i * 8192, R, C); const int Rb = Epi::PERM ? ((R & ~31) + perm32(R & 31)) : R;
        voffA[i] = (unsigned)(R * lda + C) * 2u; voffB[i] = (unsigned)(Rb * K + C) * 2u; }
    const size_t kstep = (size_t)(BK * 2);
    const size_t hstepA = (size_t)HALF * lda * 2, hstepB = (size_t)HALF * K * 2;
    const size_t tstepA = 2 * hstepA, tstepB = 2 * hstepB;
    const unsigned ldsw = (unsigned)wid * 1024u;
    const int aoff = lds_byte(wr * 64 + fr, fq * 8), boff = lds_byte(wc * 32 + fr, fq * 8);
#define PG8_SA(b, h) (((b) * 2 + (h)) * HTB)
#define PG8_SB(b, h) ((4 + (b) * 2 + (h)) * HTB)
#define PG8_STAGE(bufoff, gbase, voff) do { _Pragma("unroll") for (int _i = 0; _i < 2; ++_i) \
        __builtin_amdgcn_global_load_lds((const unsigned*)((const char*)(gbase) + (voff)[_i]), (LAS unsigned*)(lds + (bufoff) + ldsw + _i * 8192), 16, 0, 0); } while (0)
#define PG8_LDA(dst, b, h) do { _Pragma("unroll") for (int m = 0; m < 4; ++m) _Pragma("unroll") for (int k = 0; k < 2; ++k) dst[m][k] = *(const LAS bf16x8*)(lds + PG8_SA(b, h) + aoff + m * 2048 + k * 1024); } while (0)
#define PG8_LDB(dst, b, h) do { _Pragma("unroll") for (int n = 0; n < 2; ++n) _Pragma("unroll") for (int k = 0; k < 2; ++k) dst[n][k] = *(const LAS bf16x8*)(lds + PG8_SB(b, h) + boff + n * 2048 + k * 1024); } while (0)
#define PG8_MMA(ai, bj, At, Bt) do { __builtin_amdgcn_s_setprio(1); _Pragma("unroll") for (int m = 0; m < 4; ++m) _Pragma("unroll") for (int n = 0; n < 2; ++n) _Pragma("unroll") for (int k = 0; k < 2; ++k) \
        acc[ai][bj][m][n] = __builtin_amdgcn_mfma_f32_16x16x32_bf16(Bt[n][k], At[m][k], acc[ai][bj][m][n], 0, 0, 0); __builtin_amdgcn_s_setprio(0); } while (0)
#define PG8_WAIT_V(n) asm volatile("s_waitcnt vmcnt(" #n ")" ::: "memory")
#define PG8_WAIT_L(n) asm volatile("s_waitcnt lgkmcnt(" #n ")" ::: "memory")
#define PG8_BAR __builtin_amdgcn_s_barrier()
#define PG8_SCHED __builtin_amdgcn_sched_barrier(0)
    Unit cur, nxt; int ui = 0;
    if (!S.next(0, cur)) return;
    f32x4 acc[2][2][4][2];
#pragma unroll
    for (int a = 0; a < 2; ++a)
#pragma unroll
        for (int b = 0; b < 2; ++b)
#pragma unroll
            for (int m = 0; m < 4; ++m)
#pragma unroll
                for (int n = 0; n < 2; ++n) acc[a][b][m][n] = (f32x4){0.f, 0.f, 0.f, 0.f};
    bf16x8 At[4][2], B0[2][2], B1[2][2];
    const char* cA = (const char*)g.A + (size_t)cur.pm * tstepA; const char* cB = (const char*)g.Bt + (size_t)cur.pn * tstepB;
    PG8_STAGE(PG8_SB(0, 0), cB, voffB); PG8_STAGE(PG8_SB(0, 1), cB + hstepB, voffB); PG8_STAGE(PG8_SA(0, 0), cA, voffA); PG8_STAGE(PG8_SA(0, 1), cA + hstepA, voffA);
    if (wr == 1) PG8_BAR;
    PG8_WAIT_V(2); PG8_BAR;
    PG8_STAGE(PG8_SB(1, 0), cB + kstep, voffB); PG8_STAGE(PG8_SA(1, 0), cA + kstep, voffA); PG8_STAGE(PG8_SB(1, 1), cB + hstepB + kstep, voffB);
    PG8_WAIT_V(6); PG8_BAR;
    for (;;) {
        const bool has_next = S.next(ui + 1, nxt);
        const char* nA = has_next ? (const char*)g.A + (size_t)nxt.pm * tstepA : cA; const char* nB = has_next ? (const char*)g.Bt + (size_t)nxt.pn * tstepB : cB;
        for (int th = 0; th < (Epi::MID ? 2 : 1); ++th) {
        const int tb = Epi::MID ? th * Epi::MID_T : 0, te = (Epi::MID && th == 0) ? Epi::MID_T : nt;
        for (int t = tb; t < te; t += 2) {
            const bool last = (t == nt - 2);
            const char* a1 = cA + (size_t)(t + 1) * kstep;
            const char* a2 = last ? nA : cA + (size_t)(t + 2) * kstep; const char* b2 = last ? nB : cB + (size_t)(t + 2) * kstep;
            const char* a3 = a2 + kstep; const char* b3 = b2 + kstep;
            PG8_LDB(B0, 0, 0); PG8_LDB(B1, 0, 1); PG8_SCHED; PG8_LDA(At, 0, 0); PG8_STAGE(PG8_SA(1, 1), a1 + hstepA, voffA);
            PG8_WAIT_V(8); PG8_WAIT_L(0); PG8_BAR; PG8_MMA(0, 0, At, B0); PG8_MMA(0, 1, At, B1); PG8_BAR; PG8_SCHED;
            PG8_LDA(At, 0, 1); PG8_STAGE(PG8_SB(0, 0), b2, voffB); PG8_STAGE(PG8_SB(0, 1), b2 + hstepB, voffB); PG8_STAGE(PG8_SA(0, 0), a2, voffA);
            PG8_WAIT_V(8); PG8_WAIT_L(0); PG8_BAR; PG8_MMA(1, 0, At, B0); PG8_MMA(1, 1, At, B1); PG8_BAR; PG8_SCHED;
            PG8_LDB(B0, 1, 0); PG8_LDB(B1, 1, 1); PG8_SCHED; PG8_LDA(At, 1, 0); PG8_STAGE(PG8_SA(0, 1), a2 + hstepA, voffA);
            PG8_WAIT_V(8); PG8_WAIT_L(0); PG8_BAR; PG8_MMA(0, 0, At, B0); PG8_MMA(0, 1, At, B1); PG8_BAR; PG8_SCHED;
            PG8_LDA(At, 1, 1); PG8_STAGE(PG8_SB(1, 0), b3, voffB); PG8_STAGE(PG8_SB(1, 1), b3 + hstepB, voffB); PG8_STAGE(PG8_SA(1, 0), a3, voffA);
            PG8_WAIT_V(8); PG8_WAIT_L(0); PG8_BAR; PG8_MMA(1, 0, At, B0); PG8_MMA(1, 1, At, B1); PG8_BAR; PG8_SCHED;
        }
        if constexpr (Epi::MID) { if (th == 0) E.mid(acc, cur, wr, wc, fr, fq); }
        }
        if (wr == 0) PG8_BAR;
        E(acc, cur, wr, wc, fr, fq);
        if (!has_next) break;
#pragma unroll
        for (int a = 0; a < 2; ++a)
#pragma unroll
            for (int b = 0; b < 2; ++b)
#pragma unroll
                for (int m = 0; m < 4; ++m)
#pragma unroll
                    for (int n = 0; n < 2; ++n) acc[a][b][m][n] = (f32x4){0.f, 0.f, 0.f, 0.f};
        cur = nxt; cA = nA; cB = nB; ++ui;
        if (wr == 1) PG8_BAR;
    }
    PG8_WAIT_V(0);
    PG8_BAR;
#undef PG8_SA
#undef PG8_SB
#undef PG8_STAGE
#undef PG8_LDA
#undef PG8_LDB
#undef PG8_MMA
#undef PG8_WAIT_V
#undef PG8_WAIT_L
#undef PG8_BAR
#undef PG8_SCHED
}

typedef f32x4 Acc[2][2][4][2];
__device__ __forceinline__ char* sgpr_launder(const char* p) { char* q = (char*)p; asm volatile("" : "+s"(q)); return q; }
#define GPTR(T, ub, voff) ((T*)(sgpr_launder((const char*)(ub)) + (voff)))
__device__ __forceinline__ u32x4 pack8(const f32x4 v0, const f32x4 v1) { u32x4 w; w.x = cvt_pk_bf16(v0[0], v0[1]); w.y = cvt_pk_bf16(v0[2], v0[3]); w.z = cvt_pk_bf16(v1[0], v1[1]); w.w = cvt_pk_bf16(v1[2], v1[3]); return w; }

struct Epi1 {
    static constexpr bool PERM = true, MID = false; static constexpr int MID_T = 0;
    bf16_t *P, *VT, *Kc, *VTc;
    __device__ __forceinline__ void mid(Acc&, const Unit&, int, int, int, int) const {}
    __device__ __forceinline__ void operator()(const Acc& acc, const Unit& u, int wr, int wc, int fr, int fq) const {
        const bool isctx = u.pm >= (M / BM);
        if (u.pn == 4 || u.pn == 5) {
            if (!isctx) {
                const int row_u = u.pm * BM;
                char* ub = (char*)VT + ((size_t)(row_u >> 11) * 512 * SEQ + (size_t)(u.pn - 4) * 256 * SEQ + (row_u & (SEQ - 1))) * 2;
                const unsigned lo = (unsigned)((wc * 32 + 8 * fq) * SEQ + wr * 64 + fr) * 2u;
#pragma unroll
                for (int ai = 0; ai < 2; ++ai)
#pragma unroll
                    for (int m = 0; m < 4; ++m)
#pragma unroll
                        for (int bj = 0; bj < 2; ++bj)
#pragma unroll
                            for (int n = 0; n < 2; ++n) {
                                const f32x4 v = acc[ai][bj][m][n];
                                const unsigned w0 = cvt_pk_bf16(v[0], v[1]), w1 = cvt_pk_bf16(v[2], v[3]);
                                const int cst = ((bj * HALF + 4 * n) * SEQ + ai * HALF + m * 16) * 2;
                                *GPTR(bf16_t, ub + cst, lo) = (bf16_t)(w0 & 0xffffu); *GPTR(bf16_t, ub + cst + SEQ * 2, lo) = (bf16_t)(w0 >> 16);
                                *GPTR(bf16_t, ub + cst + SEQ * 4, lo) = (bf16_t)(w1 & 0xffffu); *GPTR(bf16_t, ub + cst + SEQ * 6, lo) = (bf16_t)(w1 >> 16);
                            }
            } else {
                const int rc_u = u.pm * BM - M;
                char* ub = (char*)VTc + ((size_t)(rc_u >> 8) * 512 * CTXL + (size_t)(u.pn - 4) * 256 * CTXL) * 2;
                const unsigned lo = (unsigned)((wc * 32 + 8 * fq) * CTXL + wr * 64 + fr) * 2u;
#pragma unroll
                for (int ai = 0; ai < 2; ++ai)
#pragma unroll
                    for (int m = 0; m < 4; ++m)
#pragma unroll
                        for (int bj = 0; bj < 2; ++bj)
#pragma unroll
                            for (int n = 0; n < 2; ++n) {
                                const f32x4 v = acc[ai][bj][m][n];
                                const unsigned w0 = cvt_pk_bf16(v[0], v[1]), w1 = cvt_pk_bf16(v[2], v[3]);
                                const int cst = ((bj * HALF + 4 * n) * CTXL + ai * HALF + m * 16) * 2;
                                *GPTR(bf16_t, ub + cst, lo) = (bf16_t)(w0 & 0xffffu); *GPTR(bf16_t, ub + cst + CTXL * 2, lo) = (bf16_t)(w0 >> 16);
                                *GPTR(bf16_t, ub + cst + CTXL * 4, lo) = (bf16_t)(w1 & 0xffffu); *GPTR(bf16_t, ub + cst + CTXL * 6, lo) = (bf16_t)(w1 >> 16);
                            }
            }
        } else if (isctx) {
            char* ub = (char*)Kc + ((size_t)(u.pm * BM - M) * 512 + (size_t)(u.pn * BM - 512)) * 2;
            const unsigned lo = (unsigned)((wr * 64 + fr) * 512 + wc * 32 + 8 * fq) * 2u;
#pragma unroll
            for (int ai = 0; ai < 2; ++ai)
#pragma unroll
                for (int m = 0; m < 4; ++m)
#pragma unroll
                    for (int bj = 0; bj < 2; ++bj)
                        __builtin_nontemporal_store(pack8(acc[ai][bj][m][0], acc[ai][bj][m][1]), GPTR(u32x4, ub + ((ai * HALF + m * 16) * 512 + bj * HALF) * 2, lo));
        } else if (u.pn >= 12) {
            char* ub = (char*)P + ((size_t)u.pm * BM * INW + 3072 + (size_t)(u.pn - 12) * 128) * 2;
            const unsigned lo = (unsigned)((wr * 64 + fr) * INW + wc * 32 + 8 * fq) * 2u;
#pragma unroll
            for (int ai = 0; ai < 2; ++ai)
#pragma unroll
                for (int m = 0; m < 4; ++m) {
                    f32x4 r0v, r1v, s0v, s1v;
#pragma unroll
                    for (int j = 0; j < 4; ++j) {
                        const float ea0 = fast_exp2(fminf(-LOG2E * acc[ai][0][m][0][j], 60.f)), eb0 = fast_exp2(fminf(-LOG2E * acc[ai][1][m][0][j], 60.f));
                        const float ea1 = fast_exp2(fminf(-LOG2E * acc[ai][0][m][1][j], 60.f)), eb1 = fast_exp2(fminf(-LOG2E * acc[ai][1][m][1][j], 60.f));
                        s0v[j] = fast_rcp(1.0f + eb0); s1v[j] = fast_rcp(1.0f + eb1);
                        r0v[j] = (1.0f + eb0) * fast_rcp(1.0f + ea0); r1v[j] = (1.0f + eb1) * fast_rcp(1.0f + ea1);
                    }
                    __builtin_nontemporal_store(pack8(r0v, r1v), GPTR(u32x4, ub + ((ai * HALF + m * 16) * INW) * 2, lo));
                    __builtin_nontemporal_store(pack8(s0v, s1v), GPTR(u32x4, ub + ((ai * HALF + m * 16) * INW + 1024) * 2, lo));
                }
        } else if (u.pn >= 8) {
            char* ub = (char*)P + ((size_t)u.pm * BM * INW + 2048 + (size_t)(u.pn - 8) * 128) * 2;
            const unsigned lo = (unsigned)((wr * 64 + fr) * INW + wc * 32 + 8 * fq) * 2u;
#pragma unroll
            for (int ai = 0; ai < 2; ++ai)
#pragma unroll
                for (int m = 0; m < 4; ++m)
                    __builtin_nontemporal_store(pack8(acc[ai][0][m][0] * acc[ai][1][m][0], acc[ai][0][m][1] * acc[ai][1][m][1]), GPTR(u32x4, ub + ((ai * HALF + m * 16) * INW) * 2, lo));
        } else {
            char* ub = (char*)P + ((size_t)u.pm * BM * INW + (size_t)u.pn * BM) * 2;
            const unsigned lo = (unsigned)((wr * 64 + fr) * INW + wc * 32 + 8 * fq) * 2u;
#pragma unroll
            for (int ai = 0; ai < 2; ++ai)
#pragma unroll
                for (int m = 0; m < 4; ++m)
#pragma unroll
                    for (int bj = 0; bj < 2; ++bj)
                        __builtin_nontemporal_store(pack8(acc[ai][bj][m][0], acc[ai][bj][m][1]), GPTR(u32x4, ub + ((ai * HALF + m * 16) * INW + bj * HALF) * 2, lo));
        }
    }
};

struct Epi2 {
    static constexpr bool PERM = true, MID = true; static constexpr int MID_T = 8;
    const bf16_t* P; bf16_t* Z;
    __device__ __forceinline__ void mid(Acc& acc, const Unit& u, int wr, int wc, int fr, int fq) const {
        const char* ub = (const char*)P + ((size_t)u.pm * BM * INW + (size_t)u.pn * BM + 3072) * 2;
        const unsigned lo = (unsigned)((wr * 64 + fr) * INW + wc * 32 + 8 * fq) * 2u;
        u32x4 rr[2][4][2];
#pragma unroll
        for (int ai = 0; ai < 2; ++ai)
#pragma unroll
            for (int m = 0; m < 4; ++m)
#pragma unroll
                for (int bj = 0; bj < 2; ++bj) rr[ai][m][bj] = *GPTR(const u32x4, ub + ((ai * HALF + m * 16) * INW + bj * HALF) * 2, lo);
#pragma unroll
        for (int ai = 0; ai < 2; ++ai)
#pragma unroll
            for (int m = 0; m < 4; ++m)
#pragma unroll
                for (int bj = 0; bj < 2; ++bj) {
                    const u32x4 a = rr[ai][m][bj];
                    acc[ai][bj][m][0] *= (f32x4){bf_lo(a.x), bf_hi(a.x), bf_lo(a.y), bf_hi(a.y)};
                    acc[ai][bj][m][1] *= (f32x4){bf_lo(a.z), bf_hi(a.z), bf_lo(a.w), bf_hi(a.w)};
                }
    }
    __device__ __forceinline__ void operator()(const Acc& acc, const Unit& u, int wr, int wc, int fr, int fq) const {
        const char* ub = (const char*)P + ((size_t)u.pm * BM * INW + (size_t)u.pn * BM + 4096) * 2;
        const unsigned lo = (unsigned)((wr * 64 + fr) * INW + wc * 32 + 8 * fq) * 2u;
        char* zb = (char*)Z + ((size_t)u.pm * BM * D + (size_t)u.pn * BM) * 2;
        const unsigned zlo = (unsigned)((wr * 64 + fr) * D + wc * 32 + 8 * fq) * 2u;
        u32x4 gb[2][4][2];
#pragma unroll
        for (int ai = 0; ai < 2; ++ai)
#pragma unroll
            for (int m = 0; m < 4; ++m)
#pragma unroll
                for (int bj = 0; bj < 2; ++bj) gb[ai][m][bj] = *GPTR(const u32x4, ub + ((ai * HALF + m * 16) * INW + bj * HALF) * 2, lo);
#pragma unroll
        for (int ai = 0; ai < 2; ++ai)
#pragma unroll
            for (int m = 0; m < 4; ++m)
#pragma unroll
                for (int bj = 0; bj < 2; ++bj) {
                    const u32x4 b = gb[ai][m][bj];
                    const f32x4 v0 = acc[ai][bj][m][0], v1 = acc[ai][bj][m][1];
                    u32x4 w; w.x = cvt_pk_bf16(v0[0] * bf_lo(b.x), v0[1] * bf_hi(b.x)); w.y = cvt_pk_bf16(v0[2] * bf_lo(b.y), v0[3] * bf_hi(b.y));
                    w.z = cvt_pk_bf16(v1[0] * bf_lo(b.z), v1[1] * bf_hi(b.z)); w.w = cvt_pk_bf16(v1[2] * bf_lo(b.w), v1[3] * bf_hi(b.w));
                    *GPTR(u32x4, zb + ((ai * HALF + m * 16) * D + bj * HALF) * 2, zlo) = w;
                }
    }
};

template <bool SS, int LDC, bool NT = true> struct EpiStore {
    static constexpr bool PERM = true, MID = false; static constexpr int MID_T = 0;
    bf16_t* O; float* ssp;
    __device__ __forceinline__ void mid(Acc&, const Unit&, int, int, int, int) const {}
    __device__ __forceinline__ void operator()(const Acc& acc, const Unit& u, int wr, int wc, int fr, int fq) const {
        char* ub = (char*)O + ((size_t)u.pm * BM * LDC + (size_t)u.pn * BM) * 2;
        const unsigned lo = (unsigned)((wr * 64 + fr) * LDC + wc * 32 + 8 * fq) * 2u;
        char* sb = (char*)ssp + ((size_t)u.pm * BM * 16 + (size_t)u.pn * 4) * 4;
        const unsigned slo = (unsigned)((wr * 64 + fr) * 16 + wc) * 4u;
#pragma unroll
        for (int ai = 0; ai < 2; ++ai)
#pragma unroll
            for (int m = 0; m < 4; ++m) {
                float s = 0.f;
#pragma unroll
                for (int bj = 0; bj < 2; ++bj) { const f32x4 v0 = acc[ai][bj][m][0], v1 = acc[ai][bj][m][1];
                    if (SS) s += (v0[0] * v0[0] + v0[1] * v0[1]) + (v0[2] * v0[2] + v0[3] * v0[3]) + (v1[0] * v1[0] + v1[1] * v1[1]) + (v1[2] * v1[2] + v1[3] * v1[3]);
                    if (NT) __builtin_nontemporal_store(pack8(v0, v1), GPTR(u32x4, ub + ((ai * HALF + m * 16) * LDC + bj * HALF) * 2, lo)); else *GPTR(u32x4, ub + ((ai * HALF + m * 16) * LDC + bj * HALF) * 2, lo) = pack8(v0, v1); }
                if (SS) { s += __shfl_xor(s, 16); s += __shfl_xor(s, 32); if (fq == 0) *GPTR(float, sb + (ai * HALF + m * 16) * 16 * 4, slo) = s; }
            }
    }
};
template <int CTRL> __device__ __forceinline__ float dpp_rot(float v) { return __builtin_bit_cast(float, __builtin_amdgcn_update_dpp(0, __builtin_bit_cast(int, v), CTRL, 0xf, 0xf, false)); }
__device__ __forceinline__ float gelu_tanh_f(float v) {
    const float u = v * (v * v * 0.044715f + 1.0f);
    return v * fast_rcp(1.0f + fast_exp2(u * (-1.5957691216057308f * LOG2E)));
}
struct EpiAct {
    static constexpr bool PERM = true, MID = false; static constexpr int MID_T = 0;
    bf16_t* ACT; float *SBG, *SBP, *SBA; const float *wconv, *bconv;
    __device__ __forceinline__ void mid(Acc&, const Unit&, int, int, int, int) const {}
    __device__ __forceinline__ void operator()(const Acc& acc, const Unit& u, int wr, int wc, int fr, int fq) const {
        const int ch0 = u.pn * 128 + wc * 32 + 8 * fq;
        f32x4 w0[2], w1[2], w2[2], bc[2];
#pragma unroll
        for (int n = 0; n < 2; ++n) { w0[n] = *(const f32x4*)(wconv + ch0 + 4 * n); w1[n] = *(const f32x4*)(wconv + DFF + ch0 + 4 * n); w2[n] = *(const f32x4*)(wconv + 2 * DFF + ch0 + 4 * n); bc[n] = *(const f32x4*)(bconv + ch0 + 4 * n); }
        char* ub = (char*)ACT + ((size_t)u.pm * BM * DFF + (size_t)u.pn * 128) * 2;
        const unsigned lo = (unsigned)((wr * 64 + fr) * DFF + wc * 32 + 8 * fq) * 2u;
        const bool first = fr == 0, lastl = fr == 15;
#pragma unroll
        for (int ai = 0; ai < 2; ++ai) {
            const int blk = u.pm * 4 + ai * 2 + wr;
            f32x4 Rp[2], Lc[2];
#pragma unroll
            for (int n = 0; n < 2; ++n)
#pragma unroll
                for (int e = 0; e < 4; ++e) { Rp[n][e] = 0.f; Lc[n][e] = dpp_rot<0x12F>(acc[ai][1][0][n][e]); }
#pragma unroll
            for (int m = 0; m < 4; ++m) {
                f32x4 act[2], Rc[2], Ln[2];
#pragma unroll
                for (int n = 0; n < 2; ++n)
#pragma unroll
                    for (int e = 0; e < 4; ++e) { Rc[n][e] = dpp_rot<0x121>(acc[ai][1][m][n][e]); Ln[n][e] = m < 3 ? dpp_rot<0x12F>(acc[ai][1][m < 3 ? m + 1 : 3][n][e]) : 0.f; }
#pragma unroll
                for (int n = 0; n < 2; ++n) {
                    const f32x4 g = acc[ai][1][m][n], a = acc[ai][0][m][n];
                    f32x4 prev, next;
#pragma unroll
                    for (int e = 0; e < 4; ++e) { prev[e] = first ? Rp[n][e] : Rc[n][e]; next[e] = lastl ? Ln[n][e] : Lc[n][e]; }
                    const f32x4 cv = w0[n] * prev + w1[n] * g + w2[n] * next + bc[n];
                    if (m == 0) { if (first) { const size_t o = ((size_t)blk * 2 + 0) * DFF + ch0 + 4 * n; *(f32x4*)(SBG + o) = g; *(f32x4*)(SBP + o) = cv; *(f32x4*)(SBA + o) = a; } }
                    if (m == 3) { if (lastl) { const size_t o = ((size_t)blk * 2 + 1) * DFF + ch0 + 4 * n; *(f32x4*)(SBG + o) = g; *(f32x4*)(SBP + o) = cv; *(f32x4*)(SBA + o) = a; } }
#pragma unroll
                    for (int e = 0; e < 4; ++e) act[n][e] = gelu_tanh_f(cv[e]) * a[e];
                }
                __builtin_nontemporal_store(pack8(act[0], act[1]), GPTR(u32x4, ub + (ai * HALF + m * 16) * DFF * 2, lo));
#pragma unroll
                for (int n = 0; n < 2; ++n) { Rp[n] = Rc[n]; Lc[n] = Ln[n]; }
            }
        }
    }
};
}

template <int MAP>
__device__ __forceinline__ void p0_transpose_item(const float* W, int N, bf16_t* WT, int ldt, int koff, int qlim, float qscale, LAS float* scr, int item, int lane) {
    const int nblk = N / 32, kb = item / nblk, nb = item % nblk, k0 = 64 * kb, n0 = 32 * nb;
    const int r0 = MAP == 1 ? (n0 < DFF ? (n0 / 128) * 256 + (n0 % 128) : ((n0 - DFF) / 128) * 256 + 128 + ((n0 - DFF) % 128))
                 : (MAP == 2 && n0 >= 3072) ? (n0 < 4096 ? 3072 + ((n0 - 3072) / 128) * 256 + ((n0 - 3072) % 128) : 3072 + ((n0 - 4096) / 128) * 256 + 128 + ((n0 - 4096) % 128))
                 : (MAP == 2 && n0 >= 2048) ? (n0 < 2560 ? 2048 + ((n0 - 2048) / 128) * 256 + ((n0 - 2048) % 128) : 2048 + ((n0 - 2560) / 128) * 256 + 128 + ((n0 - 2560) % 128)) : n0;
    float tv[32];
#pragma unroll
    for (int i = 0; i < 32; ++i) tv[i] = __builtin_nontemporal_load(W + (size_t)(k0 + 2 * i + (lane >> 5)) * N + n0 + (lane & 31));
#pragma unroll
    for (int i = 0; i < 32; ++i) scr[(2 * i + (lane >> 5)) * 33 + (lane & 31)] = tv[i];
    LDS_WAIT(); asm volatile("" ::: "memory");
    const int c = lane & 7;
#pragma unroll
    for (int j = 0; j < 4; ++j) { const int n = (lane >> 3) + 8 * j; const LAS float* s = scr + (8 * c) * 33 + n;
        const float sc = (n0 + n) < qlim ? qscale : 1.0f;
        u32x4 o; o.x = cvt_pk_bf16(s[0 * 33] * sc, s[1 * 33] * sc); o.y = cvt_pk_bf16(s[2 * 33] * sc, s[3 * 33] * sc); o.z = cvt_pk_bf16(s[4 * 33] * sc, s[5 * 33] * sc); o.w = cvt_pk_bf16(s[6 * 33] * sc, s[7 * 33] * sc);
        *(u32x4*)(WT + (size_t)(r0 + n) * ldt + koff + k0 + 8 * c) = o; }
    LDS_WAIT(); asm volatile("" ::: "memory");
}

__device__ __forceinline__ void phase0(const Params& p, LAS unsigned char* lds, int gw, int NGW, int wave, int lane) {
    unsigned char* ws = p.ws;
    LAS float* sl = (LAS float*)lds;
    {
        float cv[34];
#pragma unroll
        for (int k = 0; k < 34; ++k) { const int i = threadIdx.x + k * NT; cv[k] = i < 16 * D ? p.c[i] : p.c_ctx[i - 16 * D]; }
#pragma unroll
        for (int k = 0; k < 34; ++k) sl[threadIdx.x + k * NT] = cv[k] * sigmoidf_(cv[k]);
    }
    __syncthreads();
    {
        const int nit = NMOD / 16;
        float* mod = (float*)(ws + WS_MOD);
        LAS float* red = (LAS float*)(lds + 17 * D * 4);
        for (int it = blockIdx.x; it < nit; it += gridDim.x) {
            const int kg = lane >> 2, cq = lane & 3, col = it * 16 + cq * 4;
            f32x4 a[17];
#pragma unroll
            for (int b = 0; b < 17; ++b) a[b] = (f32x4){0.f, 0.f, 0.f, 0.f};
            f32x4 w[8];
#pragma unroll
            for (int i = 0; i < 8; ++i) w[i] = __builtin_nontemporal_load((const f32x4*)(p.w_ada + (size_t)(i * 128 + wave * 16 + kg) * NMOD + col));
#pragma unroll
            for (int i = 0; i < 8; ++i) {
                const int k = i * 128 + wave * 16 + kg;
#pragma unroll
                for (int b = 0; b < 17; ++b) { const float sv = sl[b * D + k]; a[b] += w[i] * sv; }
            }
#pragma unroll
            for (int b = 0; b < 17; ++b)
#pragma unroll
                for (int e = 0; e < 4; ++e) { float v = a[b][e]; v += __shfl_xor(v, 4); v += __shfl_xor(v, 8); v += __shfl_xor(v, 16); v += __shfl_xor(v, 32); a[b][e] = v; }
            if (kg == 0) {
#pragma unroll
                for (int b = 0; b < 17; ++b) *(LAS f32x4*)(red + (wave * 17 + b) * 16 + cq * 4) = a[b]; }
            __syncthreads();
            if (threadIdx.x < 17 * 16) { const int b = threadIdx.x >> 4, cc = threadIdx.x & 15; float v = p.b_ada[it * 16 + cc];
#pragma unroll
                for (int w8 = 0; w8 < 8; ++w8) v += red[(w8 * 17 + b) * 16 + cc];
                mod[(size_t)b * NMOD + it * 16 + cc] = v; }
            __syncthreads();
        }
    }
    LAS float* scr = (LAS float*)(lds + 17 * D * 4 + 8704 + wave * 8448);
    constexpr int I_IN = (D / 64) * (INW / 32), I_BA = (ATTW / 64) * (D / 32), I_BB = (CONVW / 64) * (D / 32), I_O = (D / 64) * (D / 32), I_UP = (D / 64) * (UPW / 32), I_DN = (DFF / 64) * (D / 32);
    constexpr int NITEMS = I_IN + I_BA + I_BB + I_O + I_UP + I_DN;
    for (int it = gw; it < NITEMS; it += NGW) {
        int r = it;
        if (r < I_IN) { p0_transpose_item<2>(p.w_in, INW, (bf16_t*)(ws + WS_WIN), D, 0, 512, 0.125f * LOG2E, scr, r, lane); continue; } r -= I_IN;
        if (r < I_BA) { p0_transpose_item<0>(p.w_branch_attn, D, (bf16_t*)(ws + WS_WCAT), D, 0, 0, 1.f, scr, r, lane); continue; } r -= I_BA;
        if (r < I_BB) { p0_transpose_item<0>(p.w_branch_conv, D, (bf16_t*)(ws + WS_WCAT), D, 512, 0, 1.f, scr, r, lane); continue; } r -= I_BB;
        if (r < I_O) { p0_transpose_item<0>(p.w_out, D, (bf16_t*)(ws + WS_WO), D, 0, 0, 1.f, scr, r, lane); continue; } r -= I_O;
        if (r < I_UP) { p0_transpose_item<1>(p.w_up, UPW, (bf16_t*)(ws + WS_WUP), D, 0, 0, 1.f, scr, r, lane); continue; } r -= I_UP;
        p0_transpose_item<0>(p.w_down, D, (bf16_t*)(ws + WS_WDN), DFF, 0, 0, 1.f, scr, r, lane);
    }
}

__device__ __forceinline__ void p1_load(const Params& p, int row0, int lane, f32x4 (&v)[2][4]) {
#pragma unroll
    for (int r = 0; r < 2; ++r) { const int row = row0 + r; const float* xr = row < M ? p.x + (size_t)row * D : p.ctx + (size_t)(row - M) * D;
#pragma unroll
        for (int j = 0; j < 4; ++j) v[r][j] = __builtin_nontemporal_load((const f32x4*)(xr + 4 * lane + 256 * j)); }
}
__device__ __forceinline__ void phase1(const Params& p, int gw, int NGW, int lane) {
    const float* mod = (const float*)(p.ws + WS_MOD);
    bf16_t* H = (bf16_t*)(p.ws + WS_A);
    f32x4 v[2][4], vn[2][4];
    f32x4 gq[4];
#pragma unroll
    for (int j = 0; j < 4; ++j) gq[j] = *(const f32x4*)(p.g_pre_mix + 4 * lane + 256 * j);
    const bool bm = (NGW == 2048);
    const int nsteps = bm ? 9 : (MT - gw * 2 + NGW * 2 - 1) / (NGW * 2);
    const int lbase = (gw >> 7) * SEQ + (gw & 127) * 2;
#define P1_ROW(k) (bm ? ((k) < 8 ? lbase + (k) * 256 : M + gw * 2) : gw * 2 + (k) * NGW * 2)
    f32x4 msh[4], msc[4];
    { const float* md0 = mod + (size_t)(bm ? (gw >> 7) : 0) * NMOD;
#pragma unroll
      for (int j = 0; j < 4; ++j) { const int col = 4 * lane + 256 * j; msh[j] = *(const f32x4*)(md0 + col); msc[j] = *(const f32x4*)(md0 + D + col); } }
    if (nsteps > 0) p1_load(p, P1_ROW(0), lane, v);
    for (int k = 0; k < nsteps; ++k) {
        const int row0 = P1_ROW(k);
        p1_load(p, k + 1 < nsteps ? P1_ROW(k + 1) : row0, lane, vn);
        asm volatile("" ::: "memory"); __builtin_amdgcn_sched_barrier(0);
        if (bm && k == 8) {
            const float* mdc = mod + (size_t)16 * NMOD;
#pragma unroll
            for (int j = 0; j < 4; ++j) { const int col = 4 * lane + 256 * j; msh[j] = *(const f32x4*)(mdc + col); msc[j] = *(const f32x4*)(mdc + D + col); }
        }
        float s[2];
#pragma unroll
        for (int r = 0; r < 2; ++r) { s[r] = 0.f;
#pragma unroll
            for (int j = 0; j < 4; ++j) s[r] += (v[r][j][0] * v[r][j][0] + v[r][j][1] * v[r][j][1]) + (v[r][j][2] * v[r][j][2] + v[r][j][3] * v[r][j][3]); }
#pragma unroll
        for (int r = 0; r < 2; ++r) {
            const int row = row0 + r; const int b = row < M ? (row >> 11) : 16;
            const float* md = mod + (size_t)b * NMOD;
            const float rstd = 1.0f / sqrtf(wave_sum(s[r]) * (1.0f / D) + EPS);
#pragma unroll
            for (int j = 0; j < 4; ++j) {
                const int col = 4 * lane + 256 * j;
                const f32x4 g = gq[j], sh = bm ? msh[j] : *(const f32x4*)(md + col), sc = bm ? msc[j] : *(const f32x4*)(md + D + col);
                f32x4 h = (v[r][j] * rstd) * g; h = h * (sc + 1.0f) + sh;
                u32x2 o; o.x = cvt_pk_bf16(h[0], h[1]); o.y = cvt_pk_bf16(h[2], h[3]);
                *(u32x2*)(H + (size_t)row * D + col) = o;
            }
        }
#pragma unroll
        for (int r = 0; r < 2; ++r)
#pragma unroll
            for (int j = 0; j < 4; ++j) v[r][j] = vn[r][j];
    }
#undef P1_ROW
}

struct KV { bf16x8 k[2][2]; bf16x8 v[4]; };

__device__ __forceinline__ void attn_load(KV& f, int c, int nwin, int rlo, int b, int h, int kstart, int fr, int fq,
                                          const bf16_t* P, const bf16_t* VT, const bf16_t* Kc, const bf16_t* VTc) {
    const bf16_t* kb; const bf16_t* vb; int kld, vld;
    if (c < nwin) { const int rr = rlo + c; kb = P + (size_t)(b * SEQ + rr * 64 + kstart) * INW + 512 + 64 * h; kld = INW; vb = VT + (size_t)(b * 512 + 64 * h) * SEQ + rr * 64 + kstart; vld = SEQ; }
    else { const int cc = c - nwin; kb = Kc + (size_t)(b * CTXL + cc * 32) * 512 + 64 * h; kld = 512; vb = VTc + (size_t)(b * 512 + 64 * h) * CTXL + cc * 32; vld = CTXL; }
    const int kr = 8 * (fr >> 2) + (fr & 3);
#pragma unroll
    for (int blk = 0; blk < 2; ++blk)
#pragma unroll
        for (int ds = 0; ds < 2; ++ds) f.k[blk][ds] = *(const bf16x8*)(kb + (size_t)(kr + 4 * blk) * kld + 32 * ds + 8 * fq);
#pragma unroll
    for (int db = 0; db < 4; ++db) f.v[db] = *(const bf16x8*)(vb + (size_t)(16 * db + fr) * vld + 8 * fq);
}

__device__ __forceinline__ void attn_chunk(const KV& cur, int c, int nwin, int rlo, int r0, int h, int dc0, const float (&madd)[8], const LAS float* tab,
                                           const bf16x8 (&qf)[4][2], f32x4 (&o)[4][4], float (&mrun)[4], float (&lrun)[4]) {
    constexpr int TPAD = 32;
    const bool win = c < nwin; const int rr = rlo + c;
#pragma unroll
    for (int qi = 0; qi < 4; ++qi) {
        const int r = r0 + qi, rs = min(max(r - 4, 0), 24);
        if (win && (rr < rs || rr > rs + 7)) continue;
        f32x4 s0 = (f32x4){0.f, 0.f, 0.f, 0.f}, s1 = (f32x4){0.f, 0.f, 0.f, 0.f};
        s0 = __builtin_amdgcn_mfma_f32_16x16x32_bf16(cur.k[0][0], qf[qi][0], s0, 0, 0, 0);
        s0 = __builtin_amdgcn_mfma_f32_16x16x32_bf16(cur.k[0][1], qf[qi][1], s0, 0, 0, 0);
        s1 = __builtin_amdgcn_mfma_f32_16x16x32_bf16(cur.k[1][0], qf[qi][0], s1, 0, 0, 0);
        s1 = __builtin_amdgcn_mfma_f32_16x16x32_bf16(cur.k[1][1], qf[qi][1], s1, 0, 0, 0);
        float sv[8] = {s0[0], s0[1], s0[2], s0[3], s1[0], s1[1], s1[2], s1[3]};
        if (win) {
            const LAS float* bp = tab + TPAD + h * 465 + (rr - r + 7) * 31 + dc0;
            float bv[8];
#pragma unroll
            for (int j = 0; j < 8; ++j) bv[j] = bp[j];
#pragma unroll
            for (int j = 0; j < 8; ++j) sv[j] = (sv[j] + bv[j]) + madd[j];
        }
        float mx = fmaxf(fmaxf(fmaxf(sv[0], sv[1]), fmaxf(sv[2], sv[3])), fmaxf(fmaxf(sv[4], sv[5]), fmaxf(sv[6], sv[7])));
        mx = max_x16_x32(mx);
        const float mn = fmaxf(mrun[qi], mx), alpha = fast_exp2(mrun[qi] - mn);
        mrun[qi] = mn;
        float ps = 0.f;
#pragma unroll
        for (int j = 0; j < 8; ++j) { sv[j] = fast_exp2(sv[j] - mn); ps += sv[j]; }
        lrun[qi] = lrun[qi] * alpha + ps;
        union { bf16x8 v; unsigned w[4]; } pf;
        pf.w[0] = cvt_pk_bf16(sv[0], sv[1]); pf.w[1] = cvt_pk_bf16(sv[2], sv[3]); pf.w[2] = cvt_pk_bf16(sv[4], sv[5]); pf.w[3] = cvt_pk_bf16(sv[6], sv[7]);
#pragma unroll
        for (int db = 0; db < 4; ++db) { o[qi][db] *= alpha; o[qi][db] = __builtin_amdgcn_mfma_f32_16x16x32_bf16(cur.v[db], pf.v, o[qi][db], 0, 0, 0); }
    }
}

__device__ __forceinline__ void phase3(const Params& p, LAS unsigned char* lds, int gw, int NGW, int lane) {
    const bf16_t* P = (const bf16_t*)(p.ws + WS_P); const bf16_t* VT = (const bf16_t*)(p.ws + WS_VT);
    const bf16_t* Kc = (const bf16_t*)(p.ws + WS_KC); const bf16_t* VTc = (const bf16_t*)(p.ws + WS_VTC);
    bf16_t* ATT = (bf16_t*)(p.ws + WS_A);
    constexpr int TPAD = 32, NRPB = 8 * 15 * 31;
    LAS float* tab = (LAS float*)lds;
    {
        float tv[8];
#pragma unroll
        for (int k = 0; k < 8; ++k) { const int j = (int)threadIdx.x + k * NT - TPAD; tv[k] = (j >= 0 && j < NRPB) ? p.rpb[j] * LOG2E : 0.f; }
#pragma unroll
        for (int k = 0; k < 8; ++k) { const int i = (int)threadIdx.x + k * NT; if (i < NRPB + 2 * TPAD + 64) tab[i] = tv[k]; }
    }
    __syncthreads();
    const int fr = lane & 15, fq = lane >> 4;
    for (int item = gw; item < 4096; item += NGW) {
        const int rg = item & 7, n = (item >> 3) & 3, h = (item >> 5) & 7, b = item >> 8;
        const int r0 = rg * 4;
        const int kstart = n == 0 ? 0 : (n == 1 ? 8 : (n == 2 ? 24 : 32));
        const int qcol = 16 * n + fr;
        const int cs = min(max(qcol - 8, 0), 48);
        float madd[8];
#pragma unroll
        for (int j = 0; j < 8; ++j) { const int kc = kstart + 8 * fq + j; madd[j] = (kc >= cs && kc < cs + 16) ? 0.f : -1e30f; }
        const int dc0 = kstart + 8 * fq - qcol + 15;
        const int rlo = min(max(r0 - 4, 0), 24), rhi = min(max(r0 + 3 - 4, 0), 24) + 7;
        const int nwin = rhi - rlo + 1, nch = nwin + 8;
        bf16x8 qf[4][2];
#pragma unroll
        for (int qi = 0; qi < 4; ++qi)
#pragma unroll
            for (int ds = 0; ds < 2; ++ds) qf[qi][ds] = *(const bf16x8*)(P + (size_t)(b * SEQ + (r0 + qi) * 64 + qcol) * INW + 64 * h + 32 * ds + 8 * fq);
        f32x4 o[4][4]; float mrun[4], lrun[4];
#pragma unroll
        for (int qi = 0; qi < 4; ++qi) { mrun[qi] = -1e30f; lrun[qi] = 0.f;
#pragma unroll
            for (int db = 0; db < 4; ++db) o[qi][db] = (f32x4){0.f, 0.f, 0.f, 0.f}; }
        KV ka, kb;
        attn_load(ka, 0, nwin, rlo, b, h, kstart, fr, fq, P, VT, Kc, VTc);
        for (int c = 0; c < nch; c += 2) {
            attn_load(kb, min(c + 1, nch - 1), nwin, rlo, b, h, kstart, fr, fq, P, VT, Kc, VTc);
            asm volatile("" ::: "memory"); __builtin_amdgcn_sched_barrier(0);
            attn_chunk(ka, c, nwin, rlo, r0, h, dc0, madd, tab, qf, o, mrun, lrun);
            asm volatile("" ::: "memory"); __builtin_amdgcn_sched_barrier(0);
            attn_load(ka, min(c + 2, nch - 1), nwin, rlo, b, h, kstart, fr, fq, P, VT, Kc, VTc);
            asm volatile("" ::: "memory"); __builtin_amdgcn_sched_barrier(0);
            if (c + 1 < nch) attn_chunk(kb, c + 1, nwin, rlo, r0, h, dc0, madd, tab, qf, o, mrun, lrun);
            asm volatile("" ::: "memory"); __builtin_amdgcn_sched_barrier(0);
        }
#pragma unroll
        for (int qi = 0; qi < 4; ++qi) {
            const float l = sum_x16_x32(lrun[qi]);
            const float inv = 1.0f / l;
            bf16_t* op = ATT + (size_t)(b * SEQ + (r0 + qi) * 64 + qcol) * D + 64 * h + 4 * fq;
#pragma unroll
            for (int db = 0; db < 4; ++db) { const f32x4 v = o[qi][db] * inv; u32x2 w; w.x = cvt_pk_bf16(v[0], v[1]); w.y = cvt_pk_bf16(v[2], v[3]); *(u32x2*)(op + 16 * db) = w; }
        }
    }
}
__device__ __forceinline__ void phase3b(const Params& p, int gw, int NGW, int lane) {
    const bf16_t* P = (const bf16_t*)(p.ws + WS_P); bf16_t* ATT = (bf16_t*)(p.ws + WS_A);
    {
        const int c8 = lane * 8;
        float w0[8], w1[8], w2[8];
#pragma unroll
        for (int e = 0; e < 8; ++e) { w0[e] = p.w_short_conv[c8 + e]; w1[e] = p.w_short_conv[CONVW + c8 + e]; w2[e] = p.w_short_conv[2 * CONVW + c8 + e]; }
        for (int tok0 = gw; tok0 < M; tok0 += 2 * NGW) {
            u32x4 bg[2], c0[2], c1[2], c2[2];
            const u32x4 z4 = (u32x4){0u, 0u, 0u, 0u};
#pragma unroll
            for (int r = 0; r < 2; ++r) {
                const int tok = tok0 + r * NGW, t = tok & (SEQ - 1);
                const bf16_t* rp = P + (size_t)tok * INW;
                bg[r] = __builtin_nontemporal_load((const u32x4*)(rp + 1536 + c8));
                c1[r] = *(const u32x4*)(rp + 2048 + c8);
                c0[r] = t > 0 ? *(const u32x4*)(rp - INW + 2048 + c8) : z4;
                c2[r] = t < SEQ - 1 ? *(const u32x4*)(rp + INW + 2048 + c8) : z4;
            }
#pragma unroll
            for (int r = 0; r < 2; ++r) {
                const int tok = tok0 + r * NGW;
                u32x4 o;
#pragma unroll
                for (int q = 0; q < 4; ++q) {
                    const float lo = bf_lo(bg[r][q]) * (w0[2 * q] * bf_lo(c0[r][q]) + w1[2 * q] * bf_lo(c1[r][q]) + w2[2 * q] * bf_lo(c2[r][q]));
                    const float hi = bf_hi(bg[r][q]) * (w0[2 * q + 1] * bf_hi(c0[r][q]) + w1[2 * q + 1] * bf_hi(c1[r][q]) + w2[2 * q + 1] * bf_hi(c2[r][q]));
                    o[q] = cvt_pk_bf16(lo, hi);
                }
                *(u32x4*)(ATT + (size_t)tok * D + 512 + c8) = o;
            }
        }
    }
}

__device__ __forceinline__ void p6_load(const Params& p, const bf16_t* Y, const float* ss1, int row0, int lane, f32x4 (&v)[2][4], u32x2 (&yw)[2][4], float (&ps)[2]) {
#pragma unroll
    for (int r = 0; r < 2; ++r) { const int row = row0 + r;
        ps[r] = ss1[(size_t)row * 16 + (lane & 15)];
#pragma unroll
        for (int j = 0; j < 4; ++j) { const int col = 4 * lane + 256 * j; v[r][j] = __builtin_nontemporal_load((const f32x4*)(p.x + (size_t)row * D + col)); yw[r][j] = __builtin_nontemporal_load((const u32x2*)(Y + (size_t)row * D + col)); } }
}
__device__ __forceinline__ void phase6(const Params& p, int gw, int NGW, int lane) {
    const float* mod = (const float*)(p.ws + WS_MOD);
    const bf16_t* Y = (const bf16_t*)(p.ws + WS_A);
    const float* ss1 = (const float*)(p.ws + WS_SS1);
    bf16_t* H2 = (bf16_t*)(p.ws + WS_H2);
    f32x4 v[2][4], vn[2][4]; u32x2 yw[2][4], ywn[2][4]; float ps[2], psn[2];
    f32x4 gq1[4], gq2[4];
#pragma unroll
    for (int j = 0; j < 4; ++j) { gq1[j] = *(const f32x4*)(p.g_post_mix + 4 * lane + 256 * j); gq2[j] = *(const f32x4*)(p.g_pre_ffn + 4 * lane + 256 * j); }
    const bool bm = (NGW == 2048);
    const int rstart = bm ? (gw >> 7) * SEQ + (gw & 127) * 2 : gw * 2, rstep = bm ? 256 : NGW * 2, rend = bm ? (gw >> 7) * SEQ + SEQ : M;
    f32x4 mgt[4], msh[4], msc[4];
    { const float* md0 = mod + (size_t)((rstart < M ? rstart : 0) >> 11) * NMOD;
#pragma unroll
      for (int j = 0; j < 4; ++j) { const int col = 4 * lane + 256 * j; mgt[j] = *(const f32x4*)(md0 + 2 * D + col); msh[j] = *(const f32x4*)(md0 + 3 * D + col); msc[j] = *(const f32x4*)(md0 + 4 * D + col); } }
    int row0 = rstart;
    if (row0 < rend) p6_load(p, Y, ss1, row0, lane, v, yw, ps);
    for (; row0 < rend; row0 += rstep) {
        const int nrow = row0 + rstep;
        p6_load(p, Y, ss1, nrow < rend ? nrow : row0, lane, vn, ywn, psn);
        asm volatile("" ::: "memory"); __builtin_amdgcn_sched_barrier(0);
        float s[2];
#pragma unroll
        for (int r = 0; r < 2; ++r) {
            const int row = row0 + r; const float* md = mod + (size_t)(row >> 11) * NMOD;
            float q = row16_sum(ps[r]);
            const float rstdy = 1.0f / sqrtf(q * (1.0f / D) + EPS);
            s[r] = 0.f;
#pragma unroll
            for (int j = 0; j < 4; ++j) {
                const int col = 4 * lane + 256 * j;
                const f32x4 y = (f32x4){bf_lo(yw[r][j].x), bf_hi(yw[r][j].x), bf_lo(yw[r][j].y), bf_hi(yw[r][j].y)};
                const f32x4 g = gq1[j], gt = bm ? mgt[j] : *(const f32x4*)(md + 2 * D + col);
                v[r][j] = v[r][j] + gt * ((y * rstdy) * g);
                s[r] += (v[r][j][0] * v[r][j][0] + v[r][j][1] * v[r][j][1]) + (v[r][j][2] * v[r][j][2] + v[r][j][3] * v[r][j][3]);
            }
        }
#pragma unroll
        for (int r = 0; r < 2; ++r) {
            const int row = row0 + r; const float* md = mod + (size_t)(row >> 11) * NMOD;
            const float rstd = 1.0f / sqrtf(wave_sum(s[r]) * (1.0f / D) + EPS);
#pragma unroll
            for (int j = 0; j < 4; ++j) {
                const int col = 4 * lane + 256 * j;
                const f32x4 g = gq2[j], sh = bm ? msh[j] : *(const f32x4*)(md + 3 * D + col), sc = bm ? msc[j] : *(const f32x4*)(md + 4 * D + col);
                f32x4 h = (v[r][j] * rstd) * g; h = h * (sc + 1.0f) + sh;
                u32x2 o; o.x = cvt_pk_bf16(h[0], h[1]); o.y = cvt_pk_bf16(h[2], h[3]);
                *(u32x2*)(H2 + (size_t)row * D + col) = o;
            }
        }
#pragma unroll
        for (int r = 0; r < 2; ++r) { ps[r] = psn[r];
#pragma unroll
            for (int j = 0; j < 4; ++j) { v[r][j] = vn[r][j]; yw[r][j] = ywn[r][j]; } }
    }
}

__device__ __forceinline__ void act_fixup_panel(const Params& p, int pm, int tid) {
    bf16_t* ACT = (bf16_t*)(p.ws + WS_ACT);
    const float* SBG = (const float*)(p.ws + WS_SBG); const float* SBP = (const float*)(p.ws + WS_SBP); const float* SBA = (const float*)(p.ws + WS_SBA);
    constexpr int CPR = DFF / 4;
    for (int idx = tid; idx < 8 * CPR; idx += NT) {
        const int k = idx / CPR, c4 = (idx - k * CPR) * 4, bs = pm * 8 + k, blk = bs >> 1, side = bs & 1;
        const int row = blk * 64 + (side ? 63 : 0), t = row & (SEQ - 1);
        const f32x4 part = *(const f32x4*)(SBP + (size_t)bs * DFF + c4), a = *(const f32x4*)(SBA + (size_t)bs * DFF + c4);
        f32x4 gnb = (f32x4){0.f, 0.f, 0.f, 0.f}, w;
        if (side == 0) { w = *(const f32x4*)(p.w_ffn_conv + c4); if (t > 0) gnb = *(const f32x4*)(SBG + (size_t)(bs - 1) * DFF + c4); }
        else { w = *(const f32x4*)(p.w_ffn_conv + 2 * DFF + c4); if (t < SEQ - 1) gnb = *(const f32x4*)(SBG + (size_t)(bs + 1) * DFF + c4); }
        const f32x4 cv = part + w * gnb;
        u32x2 o; o.x = cvt_pk_bf16(pg8::gelu_tanh_f(cv[0]) * a[0], pg8::gelu_tanh_f(cv[1]) * a[1]); o.y = cvt_pk_bf16(pg8::gelu_tanh_f(cv[2]) * a[2], pg8::gelu_tanh_f(cv[3]) * a[3]);
        *(u32x2*)(ACT + (size_t)row * DFF + c4) = o;
    }
}

__device__ __forceinline__ void p10_load(const Params& p, const bf16_t* Y, const bf16_t* Y2, const float* ss1, const float* ss2, int row, int lane, f32x4 (&v)[4], u32x2 (&y1)[4], u32x2 (&y2)[4], float (&ps)[2]) {
    ps[0] = ss1[(size_t)row * 16 + (lane & 15)]; ps[1] = ss2[(size_t)row * 16 + (lane & 15)];
#pragma unroll
    for (int j = 0; j < 4; ++j) { const int col = 4 * lane + 256 * j;
        v[j] = __builtin_nontemporal_load((const f32x4*)(p.x + (size_t)row * D + col));
        y1[j] = __builtin_nontemporal_load((const u32x2*)(Y + (size_t)row * D + col)); y2[j] = __builtin_nontemporal_load((const u32x2*)(Y2 + (size_t)row * D + col)); }
}
__device__ __forceinline__ void phase10(const Params& p, int gw, int NGW, int lane) {
    const float* mod = (const float*)(p.ws + WS_MOD);
    const bf16_t* Y = (const bf16_t*)(p.ws + WS_A); const bf16_t* Y2 = (const bf16_t*)(p.ws + WS_Y2);
    const float* ss1 = (const float*)(p.ws + WS_SS1); const float* ss2 = (const float*)(p.ws + WS_SS2);
    f32x4 v[4], vn[4]; u32x2 y1[4], y1n[4], y2[4], y2n[4]; float ps[2], psn[2];
    f32x4 gq1[4], gq2[4];
#pragma unroll
    for (int j = 0; j < 4; ++j) { gq1[j] = *(const f32x4*)(p.g_post_mix + 4 * lane + 256 * j); gq2[j] = *(const f32x4*)(p.g_post_ffn + 4 * lane + 256 * j); }
    const bool bm = (NGW == 2048);
    const int rstart = bm ? (gw >> 7) * SEQ + (gw & 127) : gw, rstep = bm ? 128 : NGW, rend = bm ? (gw >> 7) * SEQ + SEQ : M;
    f32x4 mt1[4], mt2[4];
    { const float* md0 = mod + (size_t)((rstart < M ? rstart : 0) >> 11) * NMOD;
#pragma unroll
      for (int j = 0; j < 4; ++j) { const int col = 4 * lane + 256 * j; mt1[j] = *(const f32x4*)(md0 + 2 * D + col); mt2[j] = *(const f32x4*)(md0 + 5 * D + col); } }
    int row = rstart;
    if (row < rend) p10_load(p, Y, Y2, ss1, ss2, row, lane, v, y1, y2, ps);
    for (; row < rend; row += rstep) {
        const int nrow = row + rstep;
        p10_load(p, Y, Y2, ss1, ss2, nrow < rend ? nrow : row, lane, vn, y1n, y2n, psn);
        asm volatile("" ::: "memory"); __builtin_amdgcn_sched_barrier(0);
        const float* md = mod + (size_t)(row >> 11) * NMOD;
        float q1 = ps[0], q2 = ps[1];
        q1 = row16_sum(q1); q2 = row16_sum(q2);
        const float r1 = 1.0f / sqrtf(q1 * (1.0f / D) + EPS), r2 = 1.0f / sqrtf(q2 * (1.0f / D) + EPS);
#pragma unroll
        for (int j = 0; j < 4; ++j) {
            const int col = 4 * lane + 256 * j;
            const f32x4 a1 = (f32x4){bf_lo(y1[j].x), bf_hi(y1[j].x), bf_lo(y1[j].y), bf_hi(y1[j].y)};
            const f32x4 a2 = (f32x4){bf_lo(y2[j].x), bf_hi(y2[j].x), bf_lo(y2[j].y), bf_hi(y2[j].y)};
            const f32x4 g1 = gq1[j], t1 = bm ? mt1[j] : *(const f32x4*)(md + 2 * D + col);
            const f32x4 g2 = gq2[j], t2 = bm ? mt2[j] : *(const f32x4*)(md + 5 * D + col);
            const f32x4 x1 = v[j] + t1 * ((a1 * r1) * g1);
            __builtin_nontemporal_store(x1 + t2 * ((a2 * r2) * g2), (f32x4*)(p.out + (size_t)row * D + col));
        }
        ps[0] = psn[0]; ps[1] = psn[1];
#pragma unroll
        for (int j = 0; j < 4; ++j) { v[j] = vn[j]; y1[j] = y1n[j]; y2[j] = y2n[j]; }
    }
}

#define XB_TMO      128
#define XB_XCNT(j)  (256  + 64 * (j))
#define XB_XSUB(j)  (1280 + 64 * (j))
#define XB_XGEN(j)  (2304 + 64 * (j))
#define XB_TOP      3328
#define XB_TOPGEN   3392
#define XCD_BAR_WORDS 3456
#define XB_SPIN_CAP (1u << 18)
__device__ __forceinline__ unsigned xb_ld(unsigned* p)              { return __hip_atomic_load(p, __ATOMIC_RELAXED, __HIP_MEMORY_SCOPE_AGENT); }
__device__ __forceinline__ unsigned xb_add(unsigned* p, unsigned v) { return __hip_atomic_fetch_add(p, v, __ATOMIC_RELAXED, __HIP_MEMORY_SCOPE_AGENT); }
__device__ __forceinline__ unsigned xb_xcc_id() { return (unsigned)__builtin_amdgcn_s_getreg((3 << 11) | 20) & 0xFu; }
#define XB_SPIN(cond, bar) do { unsigned _sp = 0; while (cond) { __builtin_amdgcn_s_sleep(1); \
    if ((++_sp & 255u) == 0u) { if (xb_ld(&(bar)[XB_TMO])) break; if (_sp > XB_SPIN_CAP) { atomicAdd(&(bar)[XB_TMO], 1u); break; } } } } while (0)
struct XcdBarrier { unsigned* bar; unsigned x; volatile LAS unsigned* st; };
__device__ __forceinline__ XcdBarrier xcd_barrier_post(unsigned* bar, volatile LAS unsigned* st) {
    XcdBarrier b; b.bar = bar; b.x = xb_xcc_id(); b.st = st;
    if (threadIdx.x == 0) (void)xb_add(&bar[XB_XCNT(b.x)], 1u);
    return b;
}
__device__ __forceinline__ void xcd_barrier_complete(unsigned* bar, unsigned x, unsigned& nloc, unsigned& nx) {
    const unsigned G = gridDim.x * gridDim.y * gridDim.z;
    unsigned sum, cnt, mine, sp = 0u;
    for (;;) {
        sum = 0u; cnt = 0u; mine = 0u;
#pragma unroll
        for (unsigned j = 0; j < 16; ++j) { const unsigned c = xb_ld(&bar[XB_XCNT(j)]); sum += c; cnt += (c > 0u) ? 1u : 0u; mine = (j == x) ? c : mine; }
        if (sum == G) break;
        __builtin_amdgcn_s_sleep(1);
        if ((++sp & 255u) == 0u) { if (xb_ld(&bar[XB_TMO])) break; if (sp > XB_SPIN_CAP) { atomicAdd(&bar[XB_TMO], 1u); break; } }
    }
    nloc = mine > 0u ? mine : 1u; nx = cnt > 0u ? cnt : 1u;
}
__device__ __forceinline__ void xcd_barrier(const XcdBarrier& b) {
    asm volatile("s_waitcnt vmcnt(0)" ::: "memory");
    __syncthreads();
    if (threadIdx.x == 0) {
        unsigned* bar = b.bar;
        __builtin_amdgcn_s_waitcnt(0);
        unsigned nloc = b.st[0], nx = b.st[1];
        if (nloc == 0u) { xcd_barrier_complete(bar, b.x, nloc, nx); b.st[0] = nloc; b.st[1] = nx; }
        const unsigned old = xb_add(&bar[XB_XSUB(b.x)], 1u);
        const unsigned gen = old / nloc;
        if (old + 1u == (gen + 1u) * nloc) {
            __builtin_amdgcn_fence(__ATOMIC_RELEASE, "agent");
            asm volatile("s_waitcnt vmcnt(0)" ::: "memory");
            const unsigned og = xb_add(&bar[XB_TOP], 1u);
            const unsigned tg = og / nx;
            if (og + 1u == (tg + 1u) * nx) xb_add(&bar[XB_TOPGEN], 1u);
            else XB_SPIN(xb_ld(&bar[XB_TOPGEN]) == tg, bar);
            __builtin_amdgcn_fence(__ATOMIC_ACQUIRE, "agent");
            xb_add(&bar[XB_XGEN(b.x)], 1u);
            asm volatile("s_waitcnt vmcnt(0)" ::: "memory");
        } else {
            XB_SPIN(xb_ld(&bar[XB_XGEN(b.x)]) == gen, bar);
            __builtin_amdgcn_fence(__ATOMIC_ACQUIRE, "agent");
            asm volatile("s_waitcnt vmcnt(0)" ::: "memory");
        }
    }
    __syncthreads();
}

__global__ void __launch_bounds__(NT, 2) mk_fwd(Params p) {
    extern __shared__ __attribute__((aligned(16))) unsigned char lds_raw[];
    LAS unsigned char* lds = (LAS unsigned char*)lds_raw;
    cg::grid_group grid = cg::this_grid();
    const int tid = threadIdx.x, lane = tid & 63, wave = __builtin_amdgcn_readfirstlane(tid >> 6);
    const int G = gridDim.x, gw = blockIdx.x * NWAVES + wave, NGW = G * NWAVES;
    unsigned char* ws = p.ws;
    volatile LAS unsigned* bst = (volatile LAS unsigned*)(lds + LDS_BYTES - 64);
    if (tid < 2) bst[tid] = 0u;
    __syncthreads();
    XcdBarrier xbar = xcd_barrier_post((unsigned*)(ws + WS_BAR), bst);
#ifdef PROBE_K
    unsigned long long pb_t0 = 0, pb_acc = 0;
#define PB_BEGIN(k) do { if (PROBE_K == (k)) pb_t0 = __builtin_amdgcn_s_memrealtime(); } while (0)
#define PB_END(k) do { if (PROBE_K == (k)) pb_acc += __builtin_amdgcn_s_memrealtime() - pb_t0; } while (0)
#else
#define PB_BEGIN(k) do {} while (0)
#define PB_END(k) do {} while (0)
#endif
#define GRID_BAR() xcd_barrier(xbar)

    PB_BEGIN(0);
#ifndef NO_P0
    phase0(p, lds, gw, NGW, wave, lane);
#endif
    if (p.ws == nullptr) grid.sync();
    GRID_BAR();
    PB_END(0);
    PB_BEGIN(1);
#ifndef NO_P1
    phase1(p, gw, NGW, lane);
#endif
    GRID_BAR();
    PB_END(1);
    PB_BEGIN(2);
    {
        pg8::Gemm g{(const bf16_t*)(ws + WS_A), (const bf16_t*)(ws + WS_WIN), D, D};
        pg8::Order S; S.init(M / 256, INW / 256, G, (int)blockIdx.x, (MC / 256) * 4);
        pg8::Epi1 E{(bf16_t*)(ws + WS_P), (bf16_t*)(ws + WS_VT), (bf16_t*)(ws + WS_KC), (bf16_t*)(ws + WS_VTC)};
#ifndef NO_G1
#ifdef STAGGER_US
        {
            const unsigned long long t0 = __builtin_amdgcn_s_memrealtime(); const unsigned long long d = (unsigned long long)(((blockIdx.x >> 3) * 5u) & 15u) * (STAGGER_US * 100ull / 16ull);
            while (__builtin_amdgcn_s_memrealtime() - t0 < d) __builtin_amdgcn_s_sleep(4);
        }
#endif
        pg8::gemm_phase<pg8::Epi1>(lds, g, S, E);
#endif
    }
    GRID_BAR();
    PB_END(2);
    PB_BEGIN(3);
#ifndef NO_P3
    PB_BEGIN(30);
    phase3(p, lds, ((G % 8 == 0) ? (int)((blockIdx.x % 8) * (G / 8) + blockIdx.x / 8) : (int)blockIdx.x) * NWAVES + wave, NGW, lane);
    __syncthreads();
    PB_END(30);
    PB_BEGIN(31);
    phase3b(p, gw, NGW, lane);
#endif
    GRID_BAR();
    PB_END(31);
    PB_END(3);
    PB_BEGIN(4);
    {
        pg8::Gemm g{(const bf16_t*)(ws + WS_A), (const bf16_t*)(ws + WS_WCAT), D, D};
        pg8::Order S; S.init(M / 256, D / 256, G, (int)blockIdx.x, 0);
        pg8::Epi2 E{(const bf16_t*)(ws + WS_P), (bf16_t*)(ws + WS_Z)};
#ifndef NO_G2
        pg8::gemm_phase<pg8::Epi2>(lds, g, S, E);
#endif
    }
    GRID_BAR();
    PB_END(4);
    PB_BEGIN(5);
    {
        pg8::Gemm g{(const bf16_t*)(ws + WS_Z), (const bf16_t*)(ws + WS_WO), D, D};
        pg8::Order S; S.init(M / 256, D / 256, G, (int)blockIdx.x, 0);
        pg8::EpiStore<true, D, false> E{(bf16_t*)(ws + WS_A), (float*)(ws + WS_SS1)};
#ifndef NO_G3
        pg8::gemm_phase<pg8::EpiStore<true, D, false>>(lds, g, S, E);
#endif
    }
    GRID_BAR();
    PB_END(5);
    PB_BEGIN(6);
#ifndef NO_P6
    phase6(p, gw, NGW, lane);
#endif
    GRID_BAR();
    PB_END(6);
    PB_BEGIN(7);
    {
        pg8::Gemm g{(const bf16_t*)(ws + WS_H2), (const bf16_t*)(ws + WS_WUP), D, D};
        pg8::Order S; S.init(M / 256, UPW / 256, G, (int)blockIdx.x, 0);
        pg8::EpiAct E{(bf16_t*)(ws + WS_ACT), (float*)(ws + WS_SBG), (float*)(ws + WS_SBP), (float*)(ws + WS_SBA), p.w_ffn_conv, p.b_ffn_conv};
#ifndef NO_G4
        pg8::gemm_phase<pg8::EpiAct>(lds, g, S, E);
#endif
    }
    GRID_BAR();
    PB_END(7);
    PB_BEGIN(9);
    {
        pg8::Gemm g{(const bf16_t*)(ws + WS_ACT), (const bf16_t*)(ws + WS_WDN), DFF, DFF};
        pg8::Order S; S.init(M / 256, D / 256, G, (int)blockIdx.x, 0);
#ifndef NO_P8
        { pg8::Unit uu; int lastpm = -1;
          for (int i = 0; S.next(i, uu); ++i) { if (uu.pm != lastpm) { act_fixup_panel(p, uu.pm, tid); lastpm = uu.pm; } }
          asm volatile("s_waitcnt vmcnt(0)" ::: "memory"); __syncthreads(); }
#endif
        pg8::EpiStore<true, D, false> E{(bf16_t*)(ws + WS_Y2), (float*)(ws + WS_SS2)};
#ifndef NO_G3
        pg8::gemm_phase<pg8::EpiStore<true, D, false>>(lds, g, S, E);
#endif
    }
    GRID_BAR();
    PB_END(9);
    PB_BEGIN(10);
    phase10(p, gw, NGW, lane);
    PB_END(10);
#ifdef PROBE_K
    if (blockIdx.x == 0 && tid == 0) { const unsigned long long t0 = __builtin_amdgcn_s_memrealtime(); while (__builtin_amdgcn_s_memrealtime() - t0 < 3ull * pb_acc) __builtin_amdgcn_s_sleep(8); }
#endif
}

extern "C" void kernel_launch(void* const* d_in, const int* in_sizes, int n_in, void* d_out, int out_size, void* d_ws, size_t ws_size, hipStream_t stream) {
    static int grid = 0;
    if (grid == 0) {
        if (n_in != 20 || in_sizes[0] != M * D || out_size != M * D || ws_size < WS_END) {
            fprintf(stderr, "kernel_launch: unexpected shapes (n_in %d, in0 %d, out %d, ws %zu; need ws >= %zu); nothing launched\n", n_in, n_in > 0 ? in_sizes[0] : -1, out_size, ws_size, (size_t)WS_END);
            grid = -1; return; }
        int dev = 0, cus = 0, per_cu = 0;
        hipGetDevice(&dev);
        hipDeviceGetAttribute(&cus, hipDeviceAttributeMultiprocessorCount, dev);
        if (hipFuncSetAttribute((const void*)mk_fwd, hipFuncAttributeMaxDynamicSharedMemorySize, LDS_BYTES) != hipSuccess) { fprintf(stderr, "kernel_launch: hipFuncSetAttribute failed\n"); grid = -1; return; }
        if (hipOccupancyMaxActiveBlocksPerMultiprocessor(&per_cu, (const void*)mk_fwd, NT, LDS_BYTES) != hipSuccess || per_cu < 1) { fprintf(stderr, "kernel_launch: occupancy query says %d\n", per_cu); per_cu = 1; }
        (void)hipGetLastError();
        grid = cus * per_cu;
    }
    if (grid < 0) return;
    Params p{};
    p.x = (const float*)d_in[0]; p.c = (const float*)d_in[1]; p.ctx = (const float*)d_in[2]; p.c_ctx = (const float*)d_in[3];
    p.w_ada = (const float*)d_in[4]; p.b_ada = (const float*)d_in[5]; p.g_pre_mix = (const float*)d_in[6]; p.g_post_mix = (const float*)d_in[7];
    p.g_pre_ffn = (const float*)d_in[8]; p.g_post_ffn = (const float*)d_in[9]; p.w_in = (const float*)d_in[10]; p.rpb = (const float*)d_in[11];
    p.w_short_conv = (const float*)d_in[12]; p.w_branch_attn = (const float*)d_in[13]; p.w_branch_conv = (const float*)d_in[14]; p.w_out = (const float*)d_in[15];
    p.w_up = (const float*)d_in[16]; p.w_ffn_conv = (const float*)d_in[17]; p.b_ffn_conv = (const float*)d_in[18]; p.w_down = (const float*)d_in[19];
    p.out = (float*)d_out; p.ws = (unsigned char*)d_ws;
    (void)hipMemsetAsync((char*)d_ws + WS_BAR, 0, 16384, stream);
    void* args[] = {&p};
    hipError_t e = hipLaunchCooperativeKernel((const void*)mk_fwd, dim3(grid), dim3(NT), args, LDS_BYTES, stream);
    if (e != hipSuccess) fprintf(stderr, "kernel_launch: cooperative launch failed: %s (grid %d)\n", hipGetErrorString(e), grid);
}
```

```cpp
#include <hip/hip_runtime.h>
#include <hip/hip_cooperative_groups.h>
#include <cstdio>
#include <cstdint>
namespace cg = cooperative_groups;

#define LAS __attribute__((address_space(3)))
typedef unsigned short bf16_t;
typedef short bf16x8 __attribute__((ext_vector_type(8)));
typedef float f32x4 __attribute__((ext_vector_type(4)));
typedef unsigned u32x4 __attribute__((ext_vector_type(4)));
typedef unsigned u32x2 __attribute__((ext_vector_type(2)));

constexpr int D = 1024, NB = 16, SEQ = 2048, M = NB * SEQ, CTXL = 256, MC = NB * CTXL, MT = M + MC;
constexpr int INW = 5120, DFF = 2816, UPW = 2 * DFF, ATTW = 512, CONVW = 512;
constexpr int NMOD = 6 * D;
constexpr float EPS = 1e-6f;
constexpr float LOG2E = 1.4426950408889634f;
constexpr int NWAVES = 8, NT = NWAVES * 64;
constexpr int LDS_BYTES = 147456;

constexpr size_t MiB = 1u << 20;
constexpr size_t WS_MOD = 0;
constexpr size_t WS_BAR = 512 * 1024;
constexpr size_t WS_SS1 = 1 * MiB;
constexpr size_t WS_SS2 = 3 * MiB;
constexpr size_t WS_WIN = 5 * MiB;
constexpr size_t WS_WCAT = 15 * MiB;
constexpr size_t WS_WO = 17 * MiB;
constexpr size_t WS_WUP = 19 * MiB;
constexpr size_t WS_WDN = 30 * MiB;
constexpr size_t WS_A = 36 * MiB;
constexpr size_t WS_P = 108 * MiB;
constexpr size_t WS_ACT = 108 * MiB;
constexpr size_t WS_SBG = 284 * MiB;
constexpr size_t WS_SBP = 295 * MiB;
constexpr size_t WS_SBA = 306 * MiB;
constexpr size_t WS_B = 428 * MiB;
constexpr size_t WS_VT = WS_B;
constexpr size_t WS_KC = WS_B + 32 * MiB;
constexpr size_t WS_VTC = WS_B + 36 * MiB;
constexpr size_t WS_Z = WS_B;
constexpr size_t WS_H2 = WS_B;
constexpr size_t WS_Y2 = WS_B;
constexpr size_t WS_END = 512 * MiB;

struct Params {
    const float *x, *c, *ctx, *c_ctx, *w_ada, *b_ada, *g_pre_mix, *g_post_mix, *g_pre_ffn, *g_post_ffn, *w_in, *rpb, *w_short_conv,
        *w_branch_attn, *w_branch_conv, *w_out, *w_up, *w_ffn_conv, *b_ffn_conv, *w_down;
    float* out;
    unsigned char* ws;
};

__device__ __forceinline__ unsigned cvt_pk_bf16(float lo, float hi) { unsigned r; asm volatile("v_cvt_pk_bf16_f32 %0, %1, %2" : "=v"(r) : "v"(lo), "v"(hi)); return r; }
__device__ __forceinline__ float bf_lo(unsigned w) { return __builtin_bit_cast(float, w << 16); }
__device__ __forceinline__ float bf_hi(unsigned w) { return __builtin_bit_cast(float, w & 0xffff0000u); }
__device__ __forceinline__ float fast_exp2(float x) { return __builtin_amdgcn_exp2f(x); }
__device__ __forceinline__ float fast_rcp(float x) { return __builtin_amdgcn_rcpf(x); }
__device__ __forceinline__ float sigmoidf_(float x) { return fast_rcp(1.0f + fast_exp2(-LOG2E * x)); }
#define LDS_WAIT() asm volatile("s_waitcnt lgkmcnt(0)" ::: "memory")
__device__ __forceinline__ void swap16(float x, float& a, float& b) { a = x; b = x; asm volatile("s_nop 1\n\tv_permlane16_swap_b32 %0, %1" : "+v"(a), "+v"(b)); }
__device__ __forceinline__ void swap32(float x, float& a, float& b) { a = x; b = x; asm volatile("s_nop 1\n\tv_permlane32_swap_b32 %0, %1" : "+v"(a), "+v"(b)); }
__device__ __forceinline__ float max_x16_x32(float x) { float a, b; swap16(x, a, b); x = fmaxf(a, b); swap32(x, a, b); return fmaxf(a, b); }
__device__ __forceinline__ float sum_x16_x32(float x) { float a, b; swap16(x, a, b); x = a + b; swap32(x, a, b); return a + b; }
template <int CTRL> __device__ __forceinline__ float dpp_f(float v) { return __builtin_bit_cast(float, __builtin_amdgcn_update_dpp(0, __builtin_bit_cast(int, v), CTRL, 0xf, 0xf, false)); }
__device__ __forceinline__ float wave_sum(float v) {
    v += dpp_f<0xB1>(v);
    v += dpp_f<0x4E>(v);
    v += dpp_f<0x124>(v);
    v += dpp_f<0x128>(v);
    return sum_x16_x32(v);
}
__device__ __forceinline__ float row16_sum(float v) { v += dpp_f<0xB1>(v); v += dpp_f<0x4E>(v); v += dpp_f<0x124>(v); v += dpp_f<0x128>(v); return v; }

namespace pg8 {
constexpr int BM = 256, BK = 64, HALF = 128, HTB = HALF * BK * 2, STAGE_BYTES = 8 * HTB, NXCD = 8, WGM = 4;
__host__ __device__ __forceinline__ int lds_byte(int r, int c) { const int st = (r >> 4) * 2 + (c >> 5), rr = r & 15, cc = c & 31, ob = rr * 64 + cc * 2; return st * 1024 + (ob ^ (((ob >> 9) & 1) << 5)); }
__host__ __device__ __forceinline__ void stage_rc(int b, int& R, int& C) { const int st = b / 1024, sb = b % 1024, swz = sb ^ (((sb >> 9) & 1) << 5); R = (st >> 1) * 16 + swz / 64; C = (st & 1) * 32 + (swz % 64) / 2; }
__host__ __device__ __forceinline__ int perm32(int rho) { const int n = rho >> 4, i = rho & 15; return 8 * (i >> 2) + 4 * n + (i & 3); }

struct Unit { int pm, pn; };
struct Gemm { const bf16_t* A; const bf16_t* Bt; int lda, K; };

struct Order {
    int nM, nN, nwg, G, c, extra;
    __device__ void init(int nM_, int nN_, int G_, int c_, int extra_) { nM = nM_; nN = nN_; nwg = nM * nN; G = G_; c = c_; extra = extra_; }
    __device__ bool next(int i, Unit& u) const {
        const long L = (long)i * G + c;
        if (L >= nwg) { const int e = (int)(L - nwg); if (e >= extra) return false; u.pm = nM + (e >> 2); u.pn = 2 + (e & 3); return true; }
        int wgid = (int)L; { const int q = nwg / NXCD, r = nwg % NXCD, xcd = wgid % NXCD, off = wgid / NXCD; wgid = (xcd < r ? xcd * (q + 1) : r * (q + 1) + (xcd - r) * q) + off; }
        const int nig = WGM * nN, gid = wgid / nig, fm = gid * WGM, gsz = (nM - fm) < WGM ? (nM - fm) : WGM;
        u.pm = fm + ((wgid % nig) % gsz); u.pn = (wgid % nig) / gsz; return true;
    }
};

template <class Epi>
__device__ __forceinline__ void gemm_phase(LAS unsigned char* lds, const Gemm g, const Order& S, const Epi& E) {
    int tid = threadIdx.x; asm volatile("" : "+v"(tid));
    const int wid = __builtin_amdgcn_readfirstlane(tid >> 6), lane = tid & 63, wr = wid >> 2, wc = wid & 3, fr = lane & 15, fq = lane >> 4;
    const int K = g.K, nt = K / BK, lda = g.lda;
    unsigned voffA[2], voffB[2];
#pragma unroll
    for (int i = 0; i < 2; ++i) { int R, C; stage_rc(tid * 16 + i * 8192, R, C); const int Rb = Epi::PERM ? ((R & ~31) + perm32(R & 31)) : R;
        voffA[i] = (unsigned)(R * lda + C) * 2u; voffB[i] = (unsigned)(Rb * K + C) * 2u; }
    const size_t kstep = (size_t)(BK * 2);
    const size_t hstepA = (size_t)HALF * lda * 2, hstepB = (size_t)HALF * K * 2;
    const size_t tstepA = 2 * hstepA, tstepB = 2 * hstepB;
    const unsigned ldsw = (unsigned)wid * 1024u;
    const int aoff = lds_byte(wr * 64 + fr, fq * 8), boff = lds_byte(wc * 32 + fr, fq * 8);
#define PG8_SA(b, h) (((b) * 2 + (h)) * HTB)
#define PG8_SB(b, h) ((4 + (b) * 2 + (h)) * HTB)
#define PG8_STAGE(bufoff, gbase, voff) do { _Pragma("unroll") for (int _i = 0; _i < 2; ++_i) \
        __builtin_amdgcn_global_load_lds((const unsigned*)((const char*)(gbase) + (voff)[_i]), (LAS unsigned*)(lds + (bufoff) + ldsw + _i * 8192), 16, 0, 0); } while (0)
#define PG8_LDA(dst, b, h) do { _Pragma("unroll") for (int m = 0; m < 4; ++m) _Pragma("unroll") for (int k = 0; k < 2; ++k) dst[m][k] = *(const LAS bf16x8*)(lds + PG8_SA(b, h) + aoff + m * 2048 + k * 1024); } while (0)
#define PG8_LDB(dst, b, h) do { _Pragma("unroll") for (int n = 0; n < 2; ++n) _Pragma("unroll") for (int k = 0; k < 2; ++k) dst[n][k] = *(const LAS bf16x8*)(lds + PG8_SB(b, h) + boff + n * 2048 + k * 1024); } while (0)
#define PG8_MMA(ai, bj, At, Bt) do { __builtin_amdgcn_s_setprio(1); _Pragma("unroll") for (int m = 0; m < 4; ++m) _Pragma("unroll") for (int n = 0; n < 2; ++n) _Pragma("unroll") for (int k = 0; k < 2; ++k) \
        acc[ai][bj][m][n] = __builtin_amdgcn_mfma_f32_16x16x32_bf16(Bt[n][k], At[m][k], acc[ai][bj][m][n], 0, 0, 0); __builtin_amdgcn_s_setprio(0); } while (0)
#define PG8_WAIT_V(n) asm volatile("s_waitcnt vmcnt(" #n ")" ::: "memory")
#define PG8_WAIT_L(n) asm volatile("s_waitcnt lgkmcnt(" #n ")" ::: "memory")
#define PG8_BAR __builtin_amdgcn_s_barrier()
#define PG8_SCHED __builtin_amdgcn_sched_barrier(0)
    Unit cur, nxt; int ui = 0;
    if (!S.next(0, cur)) return;
    f32x4 acc[2][2][4][2];
#pragma unroll
    for (int a = 0; a < 2; ++a)
#pragma unroll
        for (int b = 0; b < 2; ++b)
#pragma unroll
            for (int m = 0; m < 4; ++m)
#pragma unroll
                for (int n = 0; n < 2; ++n) acc[a][b][m][n] = (f32x4){0.f, 0.f, 0.f, 0.f};
    bf16x8 At[4][2], B0[2][2], B1[2][2];
    const char* cA = (const char*)g.A + (size_t)cur.pm * tstepA; const char* cB = (const char*)g.Bt + (size_t)cur.pn * tstepB;
    PG8_STAGE(PG8_SB(0, 0), cB, voffB); PG8_STAGE(PG8_SB(0, 1), cB + hstepB, voffB); PG8_STAGE(PG8_SA(0, 0), cA, voffA); PG8_STAGE(PG8_SA(0, 1), cA + hstepA, voffA);
    if (wr == 1) PG8_BAR;
    PG8_WAIT_V(2); PG8_BAR;
    PG8_STAGE(PG8_SB(1, 0), cB + kstep, voffB); PG8_STAGE(PG8_SA(1, 0), cA + kstep, voffA); PG8_STAGE(PG8_SB(1, 1), cB + hstepB + kstep, voffB);
    PG8_WAIT_V(6); PG8_BAR;
    for (;;) {
        const bool has_next = S.next(ui + 1, nxt);
        const char* nA = has_next ? (const char*)g.A + (size_t)nxt.pm * tstepA : cA; const char* nB = has_next ? (const char*)g.Bt + (size_t)nxt.pn * tstepB : cB;
        for (int th = 0; th < (Epi::MID ? 2 : 1); ++th) {
        const int tb = Epi::MID ? th * Epi::MID_T : 0, te = (Epi::MID && th == 0) ? Epi::MID_T : nt;
        for (int t = tb; t < te; t += 2) {
            const bool last = (t == nt - 2);
            const char* a1 = cA + (size_t)(t + 1) * kstep;
            const char* a2 = last ? nA : cA + (size_t)(t + 2) * kstep; const char* b2 = last ? nB : cB + (size_t)(t + 2) * kstep;
            const char* a3 = a2 + kstep; const char* b3 = b2 + kstep;
            PG8_LDB(B0, 0, 0); PG8_LDB(B1, 0, 1); PG8_SCHED; PG8_LDA(At, 0, 0); PG8_STAGE(PG8_SA(1, 1), a1 + hstepA, voffA);
            PG8_WAIT_V(8); PG8_WAIT_L(0); PG8_BAR; PG8_MMA(0, 0, At, B0); PG8_MMA(0, 1, At, B1); PG8_BAR; PG8_SCHED;
            PG8_LDA(At, 0, 1); PG8_STAGE(PG8_SB(0, 0), b2, voffB); PG8_STAGE(PG8_SB(0, 1), b2 + hstepB, voffB); PG8_STAGE(PG8_SA(0, 0), a2, voffA);
            PG8_WAIT_V(8); PG8_WAIT_L(0); PG8_BAR; PG8_MMA(1, 0, At, B0); PG8_MMA(1, 1, At, B1); PG8_BAR; PG8_SCHED;
            PG8_LDB(B0, 1, 0); PG8_LDB(B1, 1, 1); PG8_SCHED; PG8_LDA(At, 1, 0); PG8_STAGE(PG8_SA(0, 1), a2 + hstepA, voffA);
            PG8_WAIT_V(8); PG8_WAIT_L(0); PG8_BAR; PG8_MMA(0, 0, At, B0); PG8_MMA(0, 1, At, B1); PG8_BAR; PG8_SCHED;
            PG8_LDA(At, 1, 1); PG8_STAGE(PG8_SB(1, 0), b3, voffB); PG8_STAGE(PG8_SB(1, 1), b3 + hstepB, voffB); PG8_STAGE(PG8_SA(1, 0), a3, voffA);
            PG8_WAIT_V(8); PG8_WAIT_L(0); PG8_BAR; PG8_MMA(1, 0, At, B0); PG8_MMA(1, 1, At, B1); PG8_BAR; PG8_SCHED;
        }
        if constexpr (Epi::MID) { if (th == 0) E.mid(acc, cur, wr, wc, fr, fq); }
        }
        if (wr == 0) PG8_BAR;
        E(acc, cur, wr, wc, fr, fq);
        if (!has_next) break;
#pragma unroll
        for (int a = 0; a < 2; ++a)
#pragma unroll
            for (int b = 0; b < 2; ++b)
#pragma unroll
                for (int m = 0; m < 4; ++m)
#pragma unroll
                    for (int n = 0; n < 2; ++n) acc[a][b][m][n] = (f32x4){0.f, 0.f, 0.f, 0.f};
        cur = nxt; cA = nA; cB = nB; ++ui;
        if (wr == 1) PG8_BAR;
    }
    PG8_WAIT_V(0);
    PG8_BAR;
#undef PG8_SA
#undef PG8_SB
#undef PG8_STAGE
#undef PG8_LDA
#undef PG8_LDB
#undef PG8_MMA
#undef PG8_WAIT_V
#undef PG8_WAIT_L
#undef PG8_BAR
#undef PG8_SCHED
}

typedef f32x4 Acc[2][2][4][2];
__device__ __forceinline__ char* sgpr_launder(const char* p) { char* q = (char*)p; asm volatile("" : "+s"(q)); return q; }
#define GPTR(T, ub, voff) ((T*)(sgpr_launder((const char*)(ub)) + (voff)))
__device__ __forceinline__ u32x4 pack8(const f32x4 v0, const f32x4 v1) { u32x4 w; w.x = cvt_pk_bf16(v0[0], v0[1]); w.y = cvt_pk_bf16(v0[2], v0[3]); w.z = cvt_pk_bf16(v1[0], v1[1]); w.w = cvt_pk_bf16(v1[2], v1[3]); return w; }

struct Epi1 {
    static constexpr bool PERM = true, MID = false; static constexpr int MID_T = 0;
    bf16_t *P, *VT, *Kc, *VTc;
    __device__ __forceinline__ void mid(Acc&, const Unit&, int, int, int, int) const {}
    __device__ __forceinline__ void operator()(const Acc& acc, const Unit& u, int wr, int wc, int fr, int fq) const {
        const bool isctx = u.pm >= (M / BM);
        if (u.pn == 4 || u.pn == 5) {
            if (!isctx) {
                const int row_u = u.pm * BM;
                char* ub = (char*)VT + ((size_t)(row_u >> 11) * 512 * SEQ + (size_t)(u.pn - 4) * 256 * SEQ + (row_u & (SEQ - 1))) * 2;
                const unsigned lo = (unsigned)((wc * 32 + 8 * fq) * SEQ + wr * 64 + fr) * 2u;
#pragma unroll
                for (int ai = 0; ai < 2; ++ai)
#pragma unroll
                    for (int m = 0; m < 4; ++m)
#pragma unroll
                        for (int bj = 0; bj < 2; ++bj)
#pragma unroll
                            for (int n = 0; n < 2; ++n) {
                                const f32x4 v = acc[ai][bj][m][n];
                                const unsigned w0 = cvt_pk_bf16(v[0], v[1]), w1 = cvt_pk_bf16(v[2], v[3]);
                                const int cst = ((bj * HALF + 4 * n) * SEQ + ai * HALF + m * 16) * 2;
                                *GPTR(bf16_t, ub + cst, lo) = (bf16_t)(w0 & 0xffffu); *GPTR(bf16_t, ub + cst + SEQ * 2, lo) = (bf16_t)(w0 >> 16);
                                *GPTR(bf16_t, ub + cst + SEQ * 4, lo) = (bf16_t)(w1 & 0xffffu); *GPTR(bf16_t, ub + cst + SEQ * 6, lo) = (bf16_t)(w1 >> 16);
                            }
            } else {
                const int rc_u = u.pm * BM - M;
                char* ub = (char*)VTc + ((size_t)(rc_u >> 8) * 512 * CTXL + (size_t)(u.pn - 4) * 256 * CTXL) * 2;
                const unsigned lo = (unsigned)((wc * 32 + 8 * fq) * CTXL + wr * 64 + fr) * 2u;
#pragma unroll
                for (int ai = 0; ai < 2; ++ai)
#pragma unroll
                    for (int m = 0; m < 4; ++m)
#pragma unroll
                        for (int bj = 0; bj < 2; ++bj)
#pragma unroll
                            for (int n = 0; n < 2; ++n) {
                                const f32x4 v = acc[ai][bj][m][n];
                                const unsigned w0 = cvt_pk_bf16(v[0], v[1]), w1 = cvt_pk_bf16(v[2], v[3]);
                                const int cst = ((bj * HALF + 4 * n) * CTXL + ai * HALF + m * 16) * 2;
                                *GPTR(bf16_t, ub + cst, lo) = (bf16_t)(w0 & 0xffffu); *GPTR(bf16_t, ub + cst + CTXL * 2, lo) = (bf16_t)(w0 >> 16);
                                *GPTR(bf16_t, ub + cst + CTXL * 4, lo) = (bf16_t)(w1 & 0xffffu); *GPTR(bf16_t, ub + cst + CTXL * 6, lo) = (bf16_t)(w1 >> 16);
                            }
            }
        } else if (isctx) {
            char* ub = (char*)Kc + ((size_t)(u.pm * BM - M) * 512 + (size_t)(u.pn * BM - 512)) * 2;
            const unsigned lo = (unsigned)((wr * 64 + fr) * 512 + wc * 32 + 8 * fq) * 2u;
#pragma unroll
            for (int ai = 0; ai < 2; ++ai)
#pragma unroll
                for (int m = 0; m < 4; ++m)
#pragma unroll
                    for (int bj = 0; bj < 2; ++bj)
                        __builtin_nontemporal_store(pack8(acc[ai][bj][m][0], acc[ai][bj][m][1]), GPTR(u32x4, ub + ((ai * HALF + m * 16) * 512 + bj * HALF) * 2, lo));
        } else if (u.pn >= 12) {
            char* ub = (char*)P + ((size_t)u.pm * BM * INW + 3072 + (size_t)(u.pn - 12) * 128) * 2;
            const unsigned lo = (unsigned)((wr * 64 + fr) * INW + wc * 32 + 8 * fq) * 2u;
#pragma unroll
            for (int ai = 0; ai < 2; ++ai)
#pragma unroll
                for (int m = 0; m < 4; ++m) {
                    f32x4 r0v, r1v, s0v, s1v;
#pragma unroll
                    for (int j = 0; j < 4; ++j) {
                        const float ea0 = fast_exp2(fminf(-LOG2E * acc[ai][0][m][0][j], 60.f)), eb0 = fast_exp2(fminf(-LOG2E * acc[ai][1][m][0][j], 60.f));
                        const float ea1 = fast_exp2(fminf(-LOG2E * acc[ai][0][m][1][j], 60.f)), eb1 = fast_exp2(fminf(-LOG2E * acc[ai][1][m][1][j], 60.f));
                        s0v[j] = fast_rcp(1.0f + eb0); s1v[j] = fast_rcp(1.0f + eb1);
                        r0v[j] = (1.0f + eb0) * fast_rcp(1.0f + ea0); r1v[j] = (1.0f + eb1) * fast_rcp(1.0f + ea1);
                    }
                    __builtin_nontemporal_store(pack8(r0v, r1v), GPTR(u32x4, ub + ((ai * HALF + m * 16) * INW) * 2, lo));
                    __builtin_nontemporal_store(pack8(s0v, s1v), GPTR(u32x4, ub + ((ai * HALF + m * 16) * INW + 1024) * 2, lo));
                }
        } else if (u.pn >= 8) {
            char* ub = (char*)P + ((size_t)u.pm * BM * INW + 2048 + (size_t)(u.pn - 8) * 128) * 2;
            const unsigned lo = (unsigned)((wr * 64 + fr) * INW + wc * 32 + 8 * fq) * 2u;
#pragma unroll
            for (int ai = 0; ai < 2; ++ai)
#pragma unroll
                for (int m = 0; m < 4; ++m)
                    __builtin_nontemporal_store(pack8(acc[ai][0][m][0] * acc[ai][1][m][0], acc[ai][0][m][1] * acc[ai][1][m][1]), GPTR(u32x4, ub + ((ai * HALF + m * 16) * INW) * 2, lo));
        } else {
            char* ub = (char*)P + ((size_t)u.pm * BM * INW + (size_t)u.pn * BM) * 2;
            const unsigned lo = (unsigned)((wr * 64 + fr) * INW + wc * 32 + 8 * fq) * 2u;
#pragma unroll
            for (int ai = 0; ai < 2; ++ai)
#pragma unroll
                for (int m = 0; m < 4; ++m)
#pragma unroll
                    for (int bj = 0; bj < 2; ++bj) {
                        const u32x4 w = pack8(acc[ai][bj][m][0], acc[ai][bj][m][1]);
                        u32x4* dst = GPTR(u32x4, ub + ((ai * HALF + m * 16) * INW + bj * HALF) * 2, lo);
                        if (u.pn == 2 || u.pn == 3) *dst = w; else __builtin_nontemporal_store(w, dst);
                    }
        }
    }
};

struct Epi2 {
    static constexpr bool PERM = true, MID = true; static constexpr int MID_T = 8;
    const bf16_t* P; bf16_t* Z;
    __device__ __forceinline__ void mid(Acc& acc, const Unit& u, int wr, int wc, int fr, int fq) const {
        const char* ub = (const char*)P + ((size_t)u.pm * BM * INW + (size_t)u.pn * BM + 3072) * 2;
        const unsigned lo = (unsigned)((wr * 64 + fr) * INW + wc * 32 + 8 * fq) * 2u;
        u32x4 rr[2][4][2];
#pragma unroll
        for (int ai = 0; ai < 2; ++ai)
#pragma unroll
            for (int m = 0; m < 4; ++m)
#pragma unroll
                for (int bj = 0; bj < 2; ++bj) rr[ai][m][bj] = *GPTR(const u32x4, ub + ((ai * HALF + m * 16) * INW + bj * HALF) * 2, lo);
#pragma unroll
        for (int ai = 0; ai < 2; ++ai)
#pragma unroll
            for (int m = 0; m < 4; ++m)
#pragma unroll
                for (int bj = 0; bj < 2; ++bj) {
                    const u32x4 a = rr[ai][m][bj];
                    acc[ai][bj][m][0] *= (f32x4){bf_lo(a.x), bf_hi(a.x), bf_lo(a.y), bf_hi(a.y)};
                    acc[ai][bj][m][1] *= (f32x4){bf_lo(a.z), bf_hi(a.z), bf_lo(a.w), bf_hi(a.w)};
                }
    }
    __device__ __forceinline__ void operator()(const Acc& acc, const Unit& u, int wr, int wc, int fr, int fq) const {
        const char* ub = (const char*)P + ((size_t)u.pm * BM * INW + (size_t)u.pn * BM + 4096) * 2;
        const unsigned lo = (unsigned)((wr * 64 + fr) * INW + wc * 32 + 8 * fq) * 2u;
        char* zb = (char*)Z + ((size_t)u.pm * BM * D + (size_t)u.pn * BM) * 2;
        const unsigned zlo = (unsigned)((wr * 64 + fr) * D + wc * 32 + 8 * fq) * 2u;
        u32x4 gb[2][4][2];
#pragma unroll
        for (int ai = 0; ai < 2; ++ai)
#pragma unroll
            for (int m = 0; m < 4; ++m)
#pragma unroll
                for (int bj = 0; bj < 2; ++bj) gb[ai][m][bj] = *GPTR(const u32x4, ub + ((ai * HALF + m * 16) * INW + bj * HALF) * 2, lo);
#pragma unroll
        for (int ai = 0; ai < 2; ++ai)
#pragma unroll
            for (int m = 0; m < 4; ++m)
#pragma unroll
                for (int bj = 0; bj < 2; ++bj) {
                    const u32x4 b = gb[ai][m][bj];
                    const f32x4 v0 = acc[ai][bj][m][0], v1 = acc[ai][bj][m][1];
                    u32x4 w; w.x = cvt_pk_bf16(v0[0] * bf_lo(b.x), v0[1] * bf_hi(b.x)); w.y = cvt_pk_bf16(v0[2] * bf_lo(b.y), v0[3] * bf_hi(b.y));
                    w.z = cvt_pk_bf16(v1[0] * bf_lo(b.z), v1[1] * bf_hi(b.z)); w.w = cvt_pk_bf16(v1[2] * bf_lo(b.w), v1[3] * bf_hi(b.w));
                    *GPTR(u32x4, zb + ((ai * HALF + m * 16) * D + bj * HALF) * 2, zlo) = w;
                }
    }
};

template <bool SS, int LDC, bool NT = true> struct EpiStore {
    static constexpr bool PERM = true, MID = false; static constexpr int MID_T = 0;
    bf16_t* O; float* ssp;
    __device__ __forceinline__ void mid(Acc&, const Unit&, int, int, int, int) const {}
    __device__ __forceinline__ void operator()(const Acc& acc, const Unit& u, int wr, int wc, int fr, int fq) const {
        char* ub = (char*)O + ((size_t)u.pm * BM * LDC + (size_t)u.pn * BM) * 2;
        const unsigned lo = (unsigned)((wr * 64 + fr) * LDC + wc * 32 + 8 * fq) * 2u;
        char* sb = (char*)ssp + ((size_t)u.pm * BM * 16 + (size_t)u.pn * 4) * 4;
        const unsigned slo = (unsigned)((wr * 64 + fr) * 16 + wc) * 4u;
#pragma unroll
        for (int ai = 0; ai < 2; ++ai)
#pragma unroll
            for (int m = 0; m < 4; ++m) {
                float s = 0.f;
#pragma unroll
                for (int bj = 0; bj < 2; ++bj) { const f32x4 v0 = acc[ai][bj][m][0], v1 = acc[ai][bj][m][1];
                    if (SS) s += (v0[0] * v0[0] + v0[1] * v0[1]) + (v0[2] * v0[2] + v0[3] * v0[3]) + (v1[0] * v1[0] + v1[1] * v1[1]) + (v1[2] * v1[2] + v1[3] * v1[3]);
                    if (NT) __builtin_nontemporal_store(pack8(v0, v1), GPTR(u32x4, ub + ((ai * HALF + m * 16) * LDC + bj * HALF) * 2, lo)); else *GPTR(u32x4, ub + ((ai * HALF + m * 16) * LDC + bj * HALF) * 2, lo) = pack8(v0, v1); }
                if (SS) { s += __shfl_xor(s, 16); s += __shfl_xor(s, 32); if (fq == 0) *GPTR(float, sb + (ai * HALF + m * 16) * 16 * 4, slo) = s; }
            }
    }
};
template <int CTRL> __device__ __forceinline__ float dpp_rot(float v) { return __builtin_bit_cast(float, __builtin_amdgcn_update_dpp(0, __builtin_bit_cast(int, v), CTRL, 0xf, 0xf, false)); }
__device__ __forceinline__ float gelu_tanh_f(float v) {
    const float u = v * (v * v * 0.044715f + 1.0f);
    return v * fast_rcp(1.0f + fast_exp2(u * (-1.5957691216057308f * LOG2E)));
}
struct EpiAct {
    static constexpr bool PERM = true, MID = false; static constexpr int MID_T = 0;
    bf16_t* ACT; float *SBG, *SBP, *SBA; const float *wconv, *bconv;
    __device__ __forceinline__ void mid(Acc&, const Unit&, int, int, int, int) const {}
    __device__ __forceinline__ void operator()(const Acc& acc, const Unit& u, int wr, int wc, int fr, int fq) const {
        const int ch0 = u.pn * 128 + wc * 32 + 8 * fq;
        f32x4 w0[2], w1[2], w2[2], bc[2];
#pragma unroll
        for (int n = 0; n < 2; ++n) { w0[n] = *(const f32x4*)(wconv + ch0 + 4 * n); w1[n] = *(const f32x4*)(wconv + DFF + ch0 + 4 * n); w2[n] = *(const f32x4*)(wconv + 2 * DFF + ch0 + 4 * n); bc[n] = *(const f32x4*)(bconv + ch0 + 4 * n); }
        char* ub = (char*)ACT + ((size_t)u.pm * BM * DFF + (size_t)u.pn * 128) * 2;
        const unsigned lo = (unsigned)((wr * 64 + fr) * DFF + wc * 32 + 8 * fq) * 2u;
        const bool first = fr == 0, lastl = fr == 15;
#pragma unroll
        for (int ai = 0; ai < 2; ++ai) {
            const int blk = u.pm * 4 + ai * 2 + wr;
            f32x4 Rp[2], Lc[2];
#pragma unroll
            for (int n = 0; n < 2; ++n)
#pragma unroll
                for (int e = 0; e < 4; ++e) { Rp[n][e] = 0.f; Lc[n][e] = dpp_rot<0x12F>(acc[ai][1][0][n][e]); }
#pragma unroll
            for (int m = 0; m < 4; ++m) {
                f32x4 act[2], Rc[2], Ln[2];
#pragma unroll
                for (int n = 0; n < 2; ++n)
#pragma unroll
                    for (int e = 0; e < 4; ++e) { Rc[n][e] = dpp_rot<0x121>(acc[ai][1][m][n][e]); Ln[n][e] = m < 3 ? dpp_rot<0x12F>(acc[ai][1][m < 3 ? m + 1 : 3][n][e]) : 0.f; }
#pragma unroll
                for (int n = 0; n < 2; ++n) {
                    const f32x4 g = acc[ai][1][m][n], a = acc[ai][0][m][n];
                    f32x4 prev, next;
#pragma unroll
                    for (int e = 0; e < 4; ++e) { prev[e] = first ? Rp[n][e] : Rc[n][e]; next[e] = lastl ? Ln[n][e] : Lc[n][e]; }
                    const f32x4 cv = w0[n] * prev + w1[n] * g + w2[n] * next + bc[n];
                    if (m == 0) { if (first) { const size_t o = ((size_t)blk * 2 + 0) * DFF + ch0 + 4 * n; *(f32x4*)(SBG + o) = g; *(f32x4*)(SBP + o) = cv; *(f32x4*)(SBA + o) = a; } }
                    if (m == 3) { if (lastl) { const size_t o = ((size_t)blk * 2 + 1) * DFF + ch0 + 4 * n; *(f32x4*)(SBG + o) = g; *(f32x4*)(SBP + o) = cv; *(f32x4*)(SBA + o) = a; } }
#pragma unroll
                    for (int e = 0; e < 4; ++e) act[n][e] = gelu_tanh_f(cv[e]) * a[e];
                }
                __builtin_nontemporal_store(pack8(act[0], act[1]), GPTR(u32x4, ub + (ai * HALF + m * 16) * DFF * 2, lo));
#pragma unroll
                for (int n = 0; n < 2; ++n) { Rp[n] = Rc[n]; Lc[n] = Ln[n]; }
            }
        }
    }
};
}

template <int MAP>
__device__ __forceinline__ void p0_transpose_item(const float* W, int N, bf16_t* WT, int ldt, int koff, int qlim, float qscale, LAS float* scr, int item, int lane) {
    const int nblk = N / 32, kb = item / nblk, nb = item % nblk, k0 = 64 * kb, n0 = 32 * nb;
    const int r0 = MAP == 1 ? (n0 < DFF ? (n0 / 128) * 256 + (n0 % 128) : ((n0 - DFF) / 128) * 256 + 128 + ((n0 - DFF) % 128))
                 : (MAP == 2 && n0 >= 3072) ? (n0 < 4096 ? 3072 + ((n0 - 3072) / 128) * 256 + ((n0 - 3072) % 128) : 3072 + ((n0 - 4096) / 128) * 256 + 128 + ((n0 - 4096) % 128))
                 : (MAP == 2 && n0 >= 2048) ? (n0 < 2560 ? 2048 + ((n0 - 2048) / 128) * 256 + ((n0 - 2048) % 128) : 2048 + ((n0 - 2560) / 128) * 256 + 128 + ((n0 - 2560) % 128)) : n0;
    float tv[32];
#pragma unroll
    for (int i = 0; i < 32; ++i) tv[i] = __builtin_nontemporal_load(W + (size_t)(k0 + 2 * i + (lane >> 5)) * N + n0 + (lane & 31));
#pragma unroll
    for (int i = 0; i < 32; ++i) scr[(2 * i + (lane >> 5)) * 33 + (lane & 31)] = tv[i];
    LDS_WAIT(); asm volatile("" ::: "memory");
    const int c = lane & 7;
#pragma unroll
    for (int j = 0; j < 4; ++j) { const int n = (lane >> 3) + 8 * j; const LAS float* s = scr + (8 * c) * 33 + n;
        const float sc = (n0 + n) < qlim ? qscale : 1.0f;
        u32x4 o; o.x = cvt_pk_bf16(s[0 * 33] * sc, s[1 * 33] * sc); o.y = cvt_pk_bf16(s[2 * 33] * sc, s[3 * 33] * sc); o.z = cvt_pk_bf16(s[4 * 33] * sc, s[5 * 33] * sc); o.w = cvt_pk_bf16(s[6 * 33] * sc, s[7 * 33] * sc);
        *(u32x4*)(WT + (size_t)(r0 + n) * ldt + koff + k0 + 8 * c) = o; }
    LDS_WAIT(); asm volatile("" ::: "memory");
}

__device__ __forceinline__ void phase0(const Params& p, LAS unsigned char* lds, int gw, int NGW, int wave, int lane) {
    unsigned char* ws = p.ws;
    LAS float* sl = (LAS float*)lds;
    {
        float cv[34];
#pragma unroll
        for (int k = 0; k < 34; ++k) { const int i = threadIdx.x + k * NT; cv[k] = i < 16 * D ? p.c[i] : p.c_ctx[i - 16 * D]; }
#pragma unroll
        for (int k = 0; k < 34; ++k) sl[threadIdx.x + k * NT] = cv[k] * sigmoidf_(cv[k]);
    }
    __syncthreads();
    {
        const int nit = NMOD / 16;
        float* mod = (float*)(ws + WS_MOD);
        LAS float* red = (LAS float*)(lds + 17 * D * 4);
        for (int it = blockIdx.x; it < nit; it += gridDim.x) {
            const int kg = lane >> 2, cq = lane & 3, col = it * 16 + cq * 4;
            f32x4 a[17];
#pragma unroll
            for (int b = 0; b < 17; ++b) a[b] = (f32x4){0.f, 0.f, 0.f, 0.f};
            f32x4 w[8];
#pragma unroll
            for (int i = 0; i < 8; ++i) w[i] = __builtin_nontemporal_load((const f32x4*)(p.w_ada + (size_t)(i * 128 + wave * 16 + kg) * NMOD + col));
#pragma unroll
            for (int i = 0; i < 8; ++i) {
                const int k = i * 128 + wave * 16 + kg;
#pragma unroll
                for (int b = 0; b < 17; ++b) { const float sv = sl[b * D + k]; a[b] += w[i] * sv; }
            }
#pragma unroll
            for (int b = 0; b < 17; ++b)
#pragma unroll
                for (int e = 0; e < 4; ++e) { float v = a[b][e]; v += __shfl_xor(v, 4); v += __shfl_xor(v, 8); v += __shfl_xor(v, 16); v += __shfl_xor(v, 32); a[b][e] = v; }
            if (kg == 0) {
#pragma unroll
                for (int b = 0; b < 17; ++b) *(LAS f32x4*)(red + (wave * 17 + b) * 16 + cq * 4) = a[b]; }
            __syncthreads();
            if (threadIdx.x < 17 * 16) { const int b = threadIdx.x >> 4, cc = threadIdx.x & 15; float v = p.b_ada[it * 16 + cc];
#pragma unroll
                for (int w8 = 0; w8 < 8; ++w8) v += red[(w8 * 17 + b) * 16 + cc];
                mod[(size_t)b * NMOD + it * 16 + cc] = v; }
            __syncthreads();
        }
    }
    LAS float* scr = (LAS float*)(lds + 17 * D * 4 + 8704 + wave * 8448);
    constexpr int I_IN = (D / 64) * (INW / 32), I_BA = (ATTW / 64) * (D / 32), I_BB = (CONVW / 64) * (D / 32), I_O = (D / 64) * (D / 32), I_UP = (D / 64) * (UPW / 32), I_DN = (DFF / 64) * (D / 32);
    constexpr int NITEMS = I_IN + I_BA + I_BB + I_O + I_UP + I_DN;
    for (int it = gw; it < NITEMS; it += NGW) {
        int r = it;
        if (r < I_IN) { p0_transpose_item<2>(p.w_in, INW, (bf16_t*)(ws + WS_WIN), D, 0, 512, 0.125f * LOG2E, scr, r, lane); continue; } r -= I_IN;
        if (r < I_BA) { p0_transpose_item<0>(p.w_branch_attn, D, (bf16_t*)(ws + WS_WCAT), D, 0, 0, 1.f, scr, r, lane); continue; } r -= I_BA;
        if (r < I_BB) { p0_transpose_item<0>(p.w_branch_conv, D, (bf16_t*)(ws + WS_WCAT), D, 512, 0, 1.f, scr, r, lane); continue; } r -= I_BB;
        if (r < I_O) { p0_transpose_item<0>(p.w_out, D, (bf16_t*)(ws + WS_WO), D, 0, 0, 1.f, scr, r, lane); continue; } r -= I_O;
        if (r < I_UP) { p0_transpose_item<1>(p.w_up, UPW, (bf16_t*)(ws + WS_WUP), D, 0, 0, 1.f, scr, r, lane); continue; } r -= I_UP;
        p0_transpose_item<0>(p.w_down, D, (bf16_t*)(ws + WS_WDN), DFF, 0, 0, 1.f, scr, r, lane);
    }
}

__device__ __forceinline__ void p1_load(const Params& p, int row0, int lane, f32x4 (&v)[2][4]) {
#pragma unroll
    for (int r = 0; r < 2; ++r) { const int row = row0 + r; const float* xr = row < M ? p.x + (size_t)row * D : p.ctx + (size_t)(row - M) * D;
#pragma unroll
        for (int j = 0; j < 4; ++j) v[r][j] = __builtin_nontemporal_load((const f32x4*)(xr + 4 * lane + 256 * j)); }
}
__device__ __forceinline__ void phase1(const Params& p, int gw, int NGW, int lane) {
    const float* mod = (const float*)(p.ws + WS_MOD);
    bf16_t* H = (bf16_t*)(p.ws + WS_A);
    f32x4 v[2][4], vn[2][4];
    f32x4 gq[4];
#pragma unroll
    for (int j = 0; j < 4; ++j) gq[j] = *(const f32x4*)(p.g_pre_mix + 4 * lane + 256 * j);
    int row0 = gw * 2;
    if (row0 < MT) p1_load(p, row0, lane, v);
    for (; row0 < MT; row0 += NGW * 2) {
        const int nrow = row0 + NGW * 2;
        p1_load(p, nrow < MT ? nrow : row0, lane, vn);
        asm volatile("" ::: "memory"); __builtin_amdgcn_sched_barrier(0);
        float s[2];
#pragma unroll
        for (int r = 0; r < 2; ++r) { s[r] = 0.f;
#pragma unroll
            for (int j = 0; j < 4; ++j) s[r] += (v[r][j][0] * v[r][j][0] + v[r][j][1] * v[r][j][1]) + (v[r][j][2] * v[r][j][2] + v[r][j][3] * v[r][j][3]); }
#pragma unroll
        for (int r = 0; r < 2; ++r) {
            const int row = row0 + r; const int b = row < M ? (row >> 11) : 16;
            const float* md = mod + (size_t)b * NMOD;
            const float rstd = 1.0f / sqrtf(wave_sum(s[r]) * (1.0f / D) + EPS);
#pragma unroll
            for (int j = 0; j < 4; ++j) {
                const int col = 4 * lane + 256 * j;
                const f32x4 g = gq[j], sh = *(const f32x4*)(md + col), sc = *(const f32x4*)(md + D + col);
                f32x4 h = (v[r][j] * rstd) * g; h = h * (sc + 1.0f) + sh;
                u32x2 o; o.x = cvt_pk_bf16(h[0], h[1]); o.y = cvt_pk_bf16(h[2], h[3]);
                *(u32x2*)(H + (size_t)row * D + col) = o;
            }
        }
#pragma unroll
        for (int r = 0; r < 2; ++r)
#pragma unroll
            for (int j = 0; j < 4; ++j) v[r][j] = vn[r][j];
    }
}

struct KV { bf16x8 k[2][2]; bf16x8 v[4]; };

__device__ __forceinline__ void attn_load(KV& f, int c, int nwin, int rlo, int b, int h, int kstart, int fr, int fq,
                                          const bf16_t* P, const bf16_t* VT, const bf16_t* Kc, const bf16_t* VTc) {
    const bf16_t* kb; const bf16_t* vb; int kld, vld;
    if (c < nwin) { const int rr = rlo + c; kb = P + (size_t)(b * SEQ + rr * 64 + kstart) * INW + 512 + 64 * h; kld = INW; vb = VT + (size_t)(b * 512 + 64 * h) * SEQ + rr * 64 + kstart; vld = SEQ; }
    else { const int cc = c - nwin; kb = Kc + (size_t)(b * CTXL + cc * 32) * 512 + 64 * h; kld = 512; vb = VTc + (size_t)(b * 512 + 64 * h) * CTXL + cc * 32; vld = CTXL; }
    const int kr = 8 * (fr >> 2) + (fr & 3);
#pragma unroll
    for (int blk = 0; blk < 2; ++blk)
#pragma unroll
        for (int ds = 0; ds < 2; ++ds) f.k[blk][ds] = *(const bf16x8*)(kb + (size_t)(kr + 4 * blk) * kld + 32 * ds + 8 * fq);
#pragma unroll
    for (int db = 0; db < 4; ++db) f.v[db] = *(const bf16x8*)(vb + (size_t)(16 * db + fr) * vld + 8 * fq);
}

__device__ __forceinline__ void attn_chunk(const KV& cur, int c, int nwin, int rlo, int r0, int h, int dc0, const float (&madd)[8], const LAS float* tab,
                                           const bf16x8 (&qf)[4][2], f32x4 (&o)[4][4], float (&mrun)[4], float (&lrun)[4]) {
    constexpr int TPAD = 32;
    const bool win = c < nwin; const int rr = rlo + c;
#pragma unroll
    for (int qi = 0; qi < 4; ++qi) {
        const int r = r0 + qi, rs = min(max(r - 4, 0), 24);
        if (win && (rr < rs || rr > rs + 7)) continue;
        f32x4 s0 = (f32x4){0.f, 0.f, 0.f, 0.f}, s1 = (f32x4){0.f, 0.f, 0.f, 0.f};
        s0 = __builtin_amdgcn_mfma_f32_16x16x32_bf16(cur.k[0][0], qf[qi][0], s0, 0, 0, 0);
        s0 = __builtin_amdgcn_mfma_f32_16x16x32_bf16(cur.k[0][1], qf[qi][1], s0, 0, 0, 0);
        s1 = __builtin_amdgcn_mfma_f32_16x16x32_bf16(cur.k[1][0], qf[qi][0], s1, 0, 0, 0);
        s1 = __builtin_amdgcn_mfma_f32_16x16x32_bf16(cur.k[1][1], qf[qi][1], s1, 0, 0, 0);
        float sv[8] = {s0[0], s0[1], s0[2], s0[3], s1[0], s1[1], s1[2], s1[3]};
        if (win) {
            const LAS float* bp = tab + TPAD + h * 465 + (rr - r + 7) * 31 + dc0;
            float bv[8];
#pragma unroll
            for (int j = 0; j < 8; ++j) bv[j] = bp[j];
#pragma unroll
            for (int j = 0; j < 8; ++j) sv[j] = (sv[j] + bv[j]) + madd[j];
        }
        float mx = fmaxf(fmaxf(fmaxf(sv[0], sv[1]), fmaxf(sv[2], sv[3])), fmaxf(fmaxf(sv[4], sv[5]), fmaxf(sv[6], sv[7])));
        mx = max_x16_x32(mx);
        const float mn = fmaxf(mrun[qi], mx), alpha = fast_exp2(mrun[qi] - mn);
        mrun[qi] = mn;
        float ps = 0.f;
#pragma unroll
        for (int j = 0; j < 8; ++j) { sv[j] = fast_exp2(sv[j] - mn); ps += sv[j]; }
        lrun[qi] = lrun[qi] * alpha + ps;
        union { bf16x8 v; unsigned w[4]; } pf;
        pf.w[0] = cvt_pk_bf16(sv[0], sv[1]); pf.w[1] = cvt_pk_bf16(sv[2], sv[3]); pf.w[2] = cvt_pk_bf16(sv[4], sv[5]); pf.w[3] = cvt_pk_bf16(sv[6], sv[7]);
#pragma unroll
        for (int db = 0; db < 4; ++db) { o[qi][db] *= alpha; o[qi][db] = __builtin_amdgcn_mfma_f32_16x16x32_bf16(cur.v[db], pf.v, o[qi][db], 0, 0, 0); }
    }
}

__device__ __forceinline__ void phase3(const Params& p, LAS unsigned char* lds, int gw, int NGW, int lane) {
    const bf16_t* P = (const bf16_t*)(p.ws + WS_P); const bf16_t* VT = (const bf16_t*)(p.ws + WS_VT);
    const bf16_t* Kc = (const bf16_t*)(p.ws + WS_KC); const bf16_t* VTc = (const bf16_t*)(p.ws + WS_VTC);
    bf16_t* ATT = (bf16_t*)(p.ws + WS_A);
    constexpr int TPAD = 32, NRPB = 8 * 15 * 31;
    LAS float* tab = (LAS float*)lds;
    {
        float tv[8];
#pragma unroll
        for (int k = 0; k < 8; ++k) { const int j = (int)threadIdx.x + k * NT - TPAD; tv[k] = (j >= 0 && j < NRPB) ? p.rpb[j] * LOG2E : 0.f; }
#pragma unroll
        for (int k = 0; k < 8; ++k) { const int i = (int)threadIdx.x + k * NT; if (i < NRPB + 2 * TPAD + 64) tab[i] = tv[k]; }
    }
    __syncthreads();
    const int fr = lane & 15, fq = lane >> 4;
    for (int item = gw; item < 4096; item += NGW) {
        const int rg = item & 7, n = (item >> 3) & 3, h = (item >> 5) & 7, b = item >> 8;
        const int r0 = rg * 4;
        const int kstart = n == 0 ? 0 : (n == 1 ? 8 : (n == 2 ? 24 : 32));
        const int qcol = 16 * n + fr;
        const int cs = min(max(qcol - 8, 0), 48);
        float madd[8];
#pragma unroll
        for (int j = 0; j < 8; ++j) { const int kc = kstart + 8 * fq + j; madd[j] = (kc >= cs && kc < cs + 16) ? 0.f : -1e30f; }
        const int dc0 = kstart + 8 * fq - qcol + 15;
        const int rlo = min(max(r0 - 4, 0), 24), rhi = min(max(r0 + 3 - 4, 0), 24) + 7;
        const int nwin = rhi - rlo + 1, nch = nwin + 8;
        bf16x8 qf[4][2];
#pragma unroll
        for (int qi = 0; qi < 4; ++qi)
#pragma unroll
            for (int ds = 0; ds < 2; ++ds) qf[qi][ds] = *(const bf16x8*)(P + (size_t)(b * SEQ + (r0 + qi) * 64 + qcol) * INW + 64 * h + 32 * ds + 8 * fq);
        f32x4 o[4][4]; float mrun[4], lrun[4];
#pragma unroll
        for (int qi = 0; qi < 4; ++qi) { mrun[qi] = -1e30f; lrun[qi] = 0.f;
#pragma unroll
            for (int db = 0; db < 4; ++db) o[qi][db] = (f32x4){0.f, 0.f, 0.f, 0.f}; }
        KV ka, kb;
        attn_load(ka, 0, nwin, rlo, b, h, kstart, fr, fq, P, VT, Kc, VTc);
        for (int c = 0; c < nch; c += 2) {
            attn_load(kb, min(c + 1, nch - 1), nwin, rlo, b, h, kstart, fr, fq, P, VT, Kc, VTc);
            asm volatile("" ::: "memory"); __builtin_amdgcn_sched_barrier(0);
            attn_chunk(ka, c, nwin, rlo, r0, h, dc0, madd, tab, qf, o, mrun, lrun);
            asm volatile("" ::: "memory"); __builtin_amdgcn_sched_barrier(0);
            attn_load(ka, min(c + 2, nch - 1), nwin, rlo, b, h, kstart, fr, fq, P, VT, Kc, VTc);
            asm volatile("" ::: "memory"); __builtin_amdgcn_sched_barrier(0);
            if (c + 1 < nch) attn_chunk(kb, c + 1, nwin, rlo, r0, h, dc0, madd, tab, qf, o, mrun, lrun);
            asm volatile("" ::: "memory"); __builtin_amdgcn_sched_barrier(0);
        }
#pragma unroll
        for (int qi = 0; qi < 4; ++qi) {
            const float l = sum_x16_x32(lrun[qi]);
            const float inv = 1.0f / l;
            bf16_t* op = ATT + (size_t)(b * SEQ + (r0 + qi) * 64 + qcol) * D + 64 * h + 4 * fq;
#pragma unroll
            for (int db = 0; db < 4; ++db) { const f32x4 v = o[qi][db] * inv; u32x2 w; w.x = cvt_pk_bf16(v[0], v[1]); w.y = cvt_pk_bf16(v[2], v[3]); *(u32x2*)(op + 16 * db) = w; }
        }
    }
}
__device__ __forceinline__ void phase3b(const Params& p, int gw, int NGW, int lane) {
    const bf16_t* P = (const bf16_t*)(p.ws + WS_P); bf16_t* ATT = (bf16_t*)(p.ws + WS_A);
    {
        const int c8 = lane * 8;
        float w0[8], w1[8], w2[8];
#pragma unroll
        for (int e = 0; e < 8; ++e) { w0[e] = p.w_short_conv[c8 + e]; w1[e] = p.w_short_conv[CONVW + c8 + e]; w2[e] = p.w_short_conv[2 * CONVW + c8 + e]; }
        for (int tok0 = gw; tok0 < M; tok0 += 2 * NGW) {
            u32x4 bg[2], c0[2], c1[2], c2[2];
            const u32x4 z4 = (u32x4){0u, 0u, 0u, 0u};
#pragma unroll
            for (int r = 0; r < 2; ++r) {
                const int tok = tok0 + r * NGW, t = tok & (SEQ - 1);
                const bf16_t* rp = P + (size_t)tok * INW;
                bg[r] = __builtin_nontemporal_load((const u32x4*)(rp + 1536 + c8));
                c1[r] = *(const u32x4*)(rp + 2048 + c8);
                c0[r] = t > 0 ? *(const u32x4*)(rp - INW + 2048 + c8) : z4;
                c2[r] = t < SEQ - 1 ? *(const u32x4*)(rp + INW + 2048 + c8) : z4;
            }
#pragma unroll
            for (int r = 0; r < 2; ++r) {
                const int tok = tok0 + r * NGW;
                u32x4 o;
#pragma unroll
                for (int q = 0; q < 4; ++q) {
                    const float lo = bf_lo(bg[r][q]) * (w0[2 * q] * bf_lo(c0[r][q]) + w1[2 * q] * bf_lo(c1[r][q]) + w2[2 * q] * bf_lo(c2[r][q]));
                    const float hi = bf_hi(bg[r][q]) * (w0[2 * q + 1] * bf_hi(c0[r][q]) + w1[2 * q + 1] * bf_hi(c1[r][q]) + w2[2 * q + 1] * bf_hi(c2[r][q]));
                    o[q] = cvt_pk_bf16(lo, hi);
                }
                *(u32x4*)(ATT + (size_t)tok * D + 512 + c8) = o;
            }
        }
    }
}

__device__ __forceinline__ void p6_load(const Params& p, const bf16_t* Y, const float* ss1, int row0, int lane, f32x4 (&v)[2][4], u32x2 (&yw)[2][4], float (&ps)[2]) {
#pragma unroll
    for (int r = 0; r < 2; ++r) { const int row = row0 + r;
        ps[r] = ss1[(size_t)row * 16 + (lane & 15)];
#pragma unroll
        for (int j = 0; j < 4; ++j) { const int col = 4 * lane + 256 * j; v[r][j] = __builtin_nontemporal_load((const f32x4*)(p.x + (size_t)row * D + col)); yw[r][j] = __builtin_nontemporal_load((const u32x2*)(Y + (size_t)row * D + col)); } }
}
__device__ __forceinline__ void phase6(const Params& p, int gw, int NGW, int lane) {
    const float* mod = (const float*)(p.ws + WS_MOD);
    const bf16_t* Y = (const bf16_t*)(p.ws + WS_A);
    const float* ss1 = (const float*)(p.ws + WS_SS1);
    bf16_t* H2 = (bf16_t*)(p.ws + WS_H2);
    f32x4 v[2][4], vn[2][4]; u32x2 yw[2][4], ywn[2][4]; float ps[2], psn[2];
    f32x4 gq1[4], gq2[4];
#pragma unroll
    for (int j = 0; j < 4; ++j) { gq1[j] = *(const f32x4*)(p.g_post_mix + 4 * lane + 256 * j); gq2[j] = *(const f32x4*)(p.g_pre_ffn + 4 * lane + 256 * j); }
    const bool bm = (NGW == 2048);
    const int rstart = bm ? (gw >> 7) * SEQ + (gw & 127) * 2 : gw * 2, rstep = bm ? 256 : NGW * 2, rend = bm ? (gw >> 7) * SEQ + SEQ : M;
    f32x4 mgt[4], msh[4], msc[4];
    { const float* md0 = mod + (size_t)((rstart < M ? rstart : 0) >> 11) * NMOD;
#pragma unroll
      for (int j = 0; j < 4; ++j) { const int col = 4 * lane + 256 * j; mgt[j] = *(const f32x4*)(md0 + 2 * D + col); msh[j] = *(const f32x4*)(md0 + 3 * D + col); msc[j] = *(const f32x4*)(md0 + 4 * D + col); } }
    int row0 = rstart;
    if (row0 < rend) p6_load(p, Y, ss1, row0, lane, v, yw, ps);
    for (; row0 < rend; row0 += rstep) {
        const int nrow = row0 + rstep;
        p6_load(p, Y, ss1, nrow < rend ? nrow : row0, lane, vn, ywn, psn);
        asm volatile("" ::: "memory"); __builtin_amdgcn_sched_barrier(0);
        float s[2];
#pragma unroll
        for (int r = 0; r < 2; ++r) {
            const int row = row0 + r; const float* md = mod + (size_t)(row >> 11) * NMOD;
            float q = row16_sum(ps[r]);
            const float rstdy = 1.0f / sqrtf(q * (1.0f / D) + EPS);
            s[r] = 0.f;
#pragma unroll
            for (int j = 0; j < 4; ++j) {
                const int col = 4 * lane + 256 * j;
                const f32x4 y = (f32x4){bf_lo(yw[r][j].x), bf_hi(yw[r][j].x), bf_lo(yw[r][j].y), bf_hi(yw[r][j].y)};
                const f32x4 g = gq1[j], gt = bm ? mgt[j] : *(const f32x4*)(md + 2 * D + col);
                v[r][j] = v[r][j] + gt * ((y * rstdy) * g);
                s[r] += (v[r][j][0] * v[r][j][0] + v[r][j][1] * v[r][j][1]) + (v[r][j][2] * v[r][j][2] + v[r][j][3] * v[r][j][3]);
            }
        }
#pragma unroll
        for (int r = 0; r < 2; ++r) {
            const int row = row0 + r; const float* md = mod + (size_t)(row >> 11) * NMOD;
            const float rstd = 1.0f / sqrtf(wave_sum(s[r]) * (1.0f / D) + EPS);
#pragma unroll
            for (int j = 0; j < 4; ++j) {
                const int col = 4 * lane + 256 * j;
                const f32x4 g = gq2[j], sh = bm ? msh[j] : *(const f32x4*)(md + 3 * D + col), sc = bm ? msc[j] : *(const f32x4*)(md + 4 * D + col);
                f32x4 h = (v[r][j] * rstd) * g; h = h * (sc + 1.0f) + sh;
                u32x2 o; o.x = cvt_pk_bf16(h[0], h[1]); o.y = cvt_pk_bf16(h[2], h[3]);
                *(u32x2*)(H2 + (size_t)row * D + col) = o;
            }
        }
#pragma unroll
        for (int r = 0; r < 2; ++r) { ps[r] = psn[r];
#pragma unroll
            for (int j = 0; j < 4; ++j) { v[r][j] = vn[r][j]; yw[r][j] = ywn[r][j]; } }
    }
}

__device__ __forceinline__ void act_fixup_panel(const Params& p, int pm, int tid) {
    bf16_t* ACT = (bf16_t*)(p.ws + WS_ACT);
    const float* SBG = (const float*)(p.ws + WS_SBG); const float* SBP = (const float*)(p.ws + WS_SBP); const float* SBA = (const float*)(p.ws + WS_SBA);
    constexpr int CPR = DFF / 4;
    for (int idx = tid; idx < 8 * CPR; idx += NT) {
        const int k = idx / CPR, c4 = (idx - k * CPR) * 4, bs = pm * 8 + k, blk = bs >> 1, side = bs & 1;
        const int row = blk * 64 + (side ? 63 : 0), t = row & (SEQ - 1);
        const f32x4 part = *(const f32x4*)(SBP + (size_t)bs * DFF + c4), a = *(const f32x4*)(SBA + (size_t)bs * DFF + c4);
        f32x4 gnb = (f32x4){0.f, 0.f, 0.f, 0.f}, w;
        if (side == 0) { w = *(const f32x4*)(p.w_ffn_conv + c4); if (t > 0) gnb = *(const f32x4*)(SBG + (size_t)(bs - 1) * DFF + c4); }
        else { w = *(const f32x4*)(p.w_ffn_conv + 2 * DFF + c4); if (t < SEQ - 1) gnb = *(const f32x4*)(SBG + (size_t)(bs + 1) * DFF + c4); }
        const f32x4 cv = part + w * gnb;
        u32x2 o; o.x = cvt_pk_bf16(pg8::gelu_tanh_f(cv[0]) * a[0], pg8::gelu_tanh_f(cv[1]) * a[1]); o.y = cvt_pk_bf16(pg8::gelu_tanh_f(cv[2]) * a[2], pg8::gelu_tanh_f(cv[3]) * a[3]);
        *(u32x2*)(ACT + (size_t)row * DFF + c4) = o;
    }
}

__device__ __forceinline__ void p10_load(const Params& p, const bf16_t* Y, const bf16_t* Y2, const float* ss1, const float* ss2, int row, int lane, f32x4 (&v)[4], u32x2 (&y1)[4], u32x2 (&y2)[4], float (&ps)[2]) {
    ps[0] = ss1[(size_t)row * 16 + (lane & 15)]; ps[1] = ss2[(size_t)row * 16 + (lane & 15)];
#pragma unroll
    for (int j = 0; j < 4; ++j) { const int col = 4 * lane + 256 * j;
        v[j] = __builtin_nontemporal_load((const f32x4*)(p.x + (size_t)row * D + col));
        y1[j] = __builtin_nontemporal_load((const u32x2*)(Y + (size_t)row * D + col)); y2[j] = __builtin_nontemporal_load((const u32x2*)(Y2 + (size_t)row * D + col)); }
}
__device__ __forceinline__ void phase10(const Params& p, int gw, int NGW, int lane) {
    const float* mod = (const float*)(p.ws + WS_MOD);
    const bf16_t* Y = (const bf16_t*)(p.ws + WS_A); const bf16_t* Y2 = (const bf16_t*)(p.ws + WS_Y2);
    const float* ss1 = (const float*)(p.ws + WS_SS1); const float* ss2 = (const float*)(p.ws + WS_SS2);
    f32x4 v[4], vn[4]; u32x2 y1[4], y1n[4], y2[4], y2n[4]; float ps[2], psn[2];
    f32x4 gq1[4], gq2[4];
#pragma unroll
    for (int j = 0; j < 4; ++j) { gq1[j] = *(const f32x4*)(p.g_post_mix + 4 * lane + 256 * j); gq2[j] = *(const f32x4*)(p.g_post_ffn + 4 * lane + 256 * j); }
    const bool bm = (NGW == 2048);
    const int rstart = bm ? (gw >> 7) * SEQ + (gw & 127) : gw, rstep = bm ? 128 : NGW, rend = bm ? (gw >> 7) * SEQ + SEQ : M;
    f32x4 mt1[4], mt2[4];
    { const float* md0 = mod + (size_t)((rstart < M ? rstart : 0) >> 11) * NMOD;
#pragma unroll
      for (int j = 0; j < 4; ++j) { const int col = 4 * lane + 256 * j; mt1[j] = *(const f32x4*)(md0 + 2 * D + col); mt2[j] = *(const f32x4*)(md0 + 5 * D + col); } }
    int row = rstart;
    if (row < rend) p10_load(p, Y, Y2, ss1, ss2, row, lane, v, y1, y2, ps);
    for (; row < rend; row += rstep) {
        const int nrow = row + rstep;
        p10_load(p, Y, Y2, ss1, ss2, nrow < rend ? nrow : row, lane, vn, y1n, y2n, psn);
        asm volatile("" ::: "memory"); __builtin_amdgcn_sched_barrier(0);
        const float* md = mod + (size_t)(row >> 11) * NMOD;
        float q1 = ps[0], q2 = ps[1];
        q1 = row16_sum(q1); q2 = row16_sum(q2);
        const float r1 = 1.0f / sqrtf(q1 * (1.0f / D) + EPS), r2 = 1.0f / sqrtf(q2 * (1.0f / D) + EPS);
#pragma unroll
        for (int j = 0; j < 4; ++j) {
            const int col = 4 * lane + 256 * j;
            const f32x4 a1 = (f32x4){bf_lo(y1[j].x), bf_hi(y1[j].x), bf_lo(y1[j].y), bf_hi(y1[j].y)};
            const f32x4 a2 = (f32x4){bf_lo(y2[j].x), bf_hi(y2[j].x), bf_lo(y2[j].y), bf_hi(y2[j].y)};
            const f32x4 g1 = gq1[j], t1 = bm ? mt1[j] : *(const f32x4*)(md + 2 * D + col);
            const f32x4 g2 = gq2[j], t2 = bm ? mt2[j] : *(const f32x4*)(md + 5 * D + col);
            const f32x4 x1 = v[j] + t1 * ((a1 * r1) * g1);
            __builtin_nontemporal_store(x1 + t2 * ((a2 * r2) * g2), (f32x4*)(p.out + (size_t)row * D + col));
        }
        ps[0] = psn[0]; ps[1] = psn[1];
#pragma unroll
        for (int j = 0; j < 4; ++j) { v[j] = vn[j]; y1[j] = y1n[j]; y2[j] = y2n[j]; }
    }
}

#define XB_TMO      128
#define XB_XCNT(j)  (256  + 64 * (j))
#define XB_XSUB(j)  (1280 + 64 * (j))
#define XB_XGEN(j)  (2304 + 64 * (j))
#define XB_TOP      3328
#define XB_TOPGEN   3392
#define XCD_BAR_WORDS 3456
#define XB_SPIN_CAP (1u << 18)
__device__ __forceinline__ unsigned xb_ld(unsigned* p)              { return __hip_atomic_load(p, __ATOMIC_RELAXED, __HIP_MEMORY_SCOPE_AGENT); }
__device__ __forceinline__ unsigned xb_add(unsigned* p, unsigned v) { return __hip_atomic_fetch_add(p, v, __ATOMIC_RELAXED, __HIP_MEMORY_SCOPE_AGENT); }
__device__ __forceinline__ unsigned xb_xcc_id() { return (unsigned)__builtin_amdgcn_s_getreg((3 << 11) | 20) & 0xFu; }
#define XB_SPIN(cond, bar) do { unsigned _sp = 0; while (cond) { __builtin_amdgcn_s_sleep(1); \
    if ((++_sp & 255u) == 0u) { if (xb_ld(&(bar)[XB_TMO])) break; if (_sp > XB_SPIN_CAP) { atomicAdd(&(bar)[XB_TMO], 1u); break; } } } } while (0)
struct XcdBarrier { unsigned* bar; unsigned x; volatile LAS unsigned* st; };
__device__ __forceinline__ XcdBarrier xcd_barrier_post(unsigned* bar, volatile LAS unsigned* st) {
    XcdBarrier b; b.bar = bar; b.x = xb_xcc_id(); b.st = st;
    if (threadIdx.x == 0) (void)xb_add(&bar[XB_XCNT(b.x)], 1u);
    return b;
}
__device__ __forceinline__ void xcd_barrier_complete(unsigned* bar, unsigned x, unsigned& nloc, unsigned& nx) {
    const unsigned G = gridDim.x * gridDim.y * gridDim.z;
    unsigned sum, cnt, mine, sp = 0u;
    for (;;) {
        sum = 0u; cnt = 0u; mine = 0u;
#pragma unroll
        for (unsigned j = 0; j < 16; ++j) { const unsigned c = xb_ld(&bar[XB_XCNT(j)]); sum += c; cnt += (c > 0u) ? 1u : 0u; mine = (j == x) ? c : mine; }
        if (sum == G) break;
        __builtin_amdgcn_s_sleep(1);
        if ((++sp & 255u) == 0u) { if (xb_ld(&bar[XB_TMO])) break; if (sp > XB_SPIN_CAP) { atomicAdd(&bar[XB_TMO], 1u); break; } }
    }
    nloc = mine > 0u ? mine : 1u; nx = cnt > 0u ? cnt : 1u;
}
__device__ __forceinline__ void xcd_barrier(const XcdBarrier& b) {
    asm volatile("s_waitcnt vmcnt(0)" ::: "memory");
    __syncthreads();
    if (threadIdx.x == 0) {
        unsigned* bar = b.bar;
        __builtin_amdgcn_s_waitcnt(0);
        unsigned nloc = b.st[0], nx = b.st[1];
        if (nloc == 0u) { xcd_barrier_complete(bar, b.x, nloc, nx); b.st[0] = nloc; b.st[1] = nx; }
        const unsigned old = xb_add(&bar[XB_XSUB(b.x)], 1u);
        const unsigned gen = old / nloc;
        if (old + 1u == (gen + 1u) * nloc) {
            __builtin_amdgcn_fence(__ATOMIC_RELEASE, "agent");
            asm volatile("s_waitcnt vmcnt(0)" ::: "memory");
            const unsigned og = xb_add(&bar[XB_TOP], 1u);
            const unsigned tg = og / nx;
            if (og + 1u == (tg + 1u) * nx) xb_add(&bar[XB_TOPGEN], 1u);
            else XB_SPIN(xb_ld(&bar[XB_TOPGEN]) == tg, bar);
            __builtin_amdgcn_fence(__ATOMIC_ACQUIRE, "agent");
            xb_add(&bar[XB_XGEN(b.x)], 1u);
            asm volatile("s_waitcnt vmcnt(0)" ::: "memory");
        } else {
            XB_SPIN(xb_ld(&bar[XB_XGEN(b.x)]) == gen, bar);
            __builtin_amdgcn_fence(__ATOMIC_ACQUIRE, "agent");
            asm volatile("s_waitcnt vmcnt(0)" ::: "memory");
        }
    }
    __syncthreads();
}

__global__ void __launch_bounds__(NT, 2) mk_fwd(Params p) {
    extern __shared__ __attribute__((aligned(16))) unsigned char lds_raw[];
    LAS unsigned char* lds = (LAS unsigned char*)lds_raw;
    cg::grid_group grid = cg::this_grid();
    const int tid = threadIdx.x, lane = tid & 63, wave = __builtin_amdgcn_readfirstlane(tid >> 6);
    const int G = gridDim.x, gw = blockIdx.x * NWAVES + wave, NGW = G * NWAVES;
    unsigned char* ws = p.ws;
    volatile LAS unsigned* bst = (volatile LAS unsigned*)(lds + LDS_BYTES - 64);
    if (tid < 2) bst[tid] = 0u;
    __syncthreads();
    XcdBarrier xbar = xcd_barrier_post((unsigned*)(ws + WS_BAR), bst);
#ifdef PROBE_K
    unsigned long long pb_t0 = 0, pb_acc = 0;
#define PB_BEGIN(k) do { if (PROBE_K == (k)) pb_t0 = __builtin_amdgcn_s_memrealtime(); } while (0)
#define PB_END(k) do { if (PROBE_K == (k)) pb_acc += __builtin_amdgcn_s_memrealtime() - pb_t0; } while (0)
#else
#define PB_BEGIN(k) do {} while (0)
#define PB_END(k) do {} while (0)
#endif
#define GRID_BAR() xcd_barrier(xbar)

    PB_BEGIN(0);
#ifndef NO_P0
    phase0(p, lds, gw, NGW, wave, lane);
#endif
    if (p.ws == nullptr) grid.sync();
    GRID_BAR();
    PB_END(0);
    PB_BEGIN(1);
#ifndef NO_P1
    phase1(p, gw, NGW, lane);
#endif
    GRID_BAR();
    PB_END(1);
    PB_BEGIN(2);
    {
        pg8::Gemm g{(const bf16_t*)(ws + WS_A), (const bf16_t*)(ws + WS_WIN), D, D};
        pg8::Order S; S.init(M / 256, INW / 256, G, (int)blockIdx.x, (MC / 256) * 4);
        pg8::Epi1 E{(bf16_t*)(ws + WS_P), (bf16_t*)(ws + WS_VT), (bf16_t*)(ws + WS_KC), (bf16_t*)(ws + WS_VTC)};
#ifndef NO_G1
#ifdef STAGGER_US
        {
            const unsigned long long t0 = __builtin_amdgcn_s_memrealtime(); const unsigned long long d = (unsigned long long)(((blockIdx.x >> 3) * 5u) & 15u) * (STAGGER_US * 100ull / 16ull);
            while (__builtin_amdgcn_s_memrealtime() - t0 < d) __builtin_amdgcn_s_sleep(4);
        }
#endif
        pg8::gemm_phase<pg8::Epi1>(lds, g, S, E);
#endif
    }
    GRID_BAR();
    PB_END(2);
    PB_BEGIN(3);
#ifndef NO_P3
    PB_BEGIN(30);
    phase3(p, lds, ((G % 8 == 0) ? (int)((blockIdx.x % 8) * (G / 8) + blockIdx.x / 8) : (int)blockIdx.x) * NWAVES + wave, NGW, lane);
    __syncthreads();
    PB_END(30);
    PB_BEGIN(31);
    phase3b(p, gw, NGW, lane);
#endif
    GRID_BAR();
    PB_END(31);
    PB_END(3);
    PB_BEGIN(4);
    {
        pg8::Gemm g{(const bf16_t*)(ws + WS_A), (const bf16_t*)(ws + WS_WCAT), D, D};
        pg8::Order S; S.init(M / 256, D / 256, G, (int)blockIdx.x, 0);
        pg8::Epi2 E{(const bf16_t*)(ws + WS_P), (bf16_t*)(ws + WS_Z)};
#ifndef NO_G2
        pg8::gemm_phase<pg8::Epi2>(lds, g, S, E);
#endif
    }
    GRID_BAR();
    PB_END(4);
    PB_BEGIN(5);
    {
        pg8::Gemm g{(const bf16_t*)(ws + WS_Z), (const bf16_t*)(ws + WS_WO), D, D};
        pg8::Order S; S.init(M / 256, D / 256, G, (int)blockIdx.x, 0);
        pg8::EpiStore<true, D, false> E{(bf16_t*)(ws + WS_A), (float*)(ws + WS_SS1)};
#ifndef NO_G3
        pg8::gemm_phase<pg8::EpiStore<true, D, false>>(lds, g, S, E);
#endif
    }
    GRID_BAR();
    PB_END(5);
    PB_BEGIN(6);
#ifndef NO_P6
    phase6(p, gw, NGW, lane);
#endif
    GRID_BAR();
    PB_END(6);
    PB_BEGIN(7);
    {
        pg8::Gemm g{(const bf16_t*)(ws + WS_H2), (const bf16_t*)(ws + WS_WUP), D, D};
        pg8::Order S; S.init(M / 256, UPW / 256, G, (int)blockIdx.x, 0);
        pg8::EpiAct E{(bf16_t*)(ws + WS_ACT), (float*)(ws + WS_SBG), (float*)(ws + WS_SBP), (float*)(ws + WS_SBA), p.w_ffn_conv, p.b_ffn_conv};
#ifndef NO_G4
        pg8::gemm_phase<pg8::EpiAct>(lds, g, S, E);
#endif
    }
    GRID_BAR();
    PB_END(7);
    PB_BEGIN(9);
    {
        pg8::Gemm g{(const bf16_t*)(ws + WS_ACT), (const bf16_t*)(ws + WS_WDN), DFF, DFF};
        pg8::Order S; S.init(M / 256, D / 256, G, (int)blockIdx.x, 0);
#ifndef NO_P8
        { pg8::Unit uu; int lastpm = -1;
          for (int i = 0; S.next(i, uu); ++i) { if (uu.pm != lastpm) { act_fixup_panel(p, uu.pm, tid); lastpm = uu.pm; } }
          asm volatile("s_waitcnt vmcnt(0)" ::: "memory"); __syncthreads(); }
#endif
        pg8::EpiStore<true, D, false> E{(bf16_t*)(ws + WS_Y2), (float*)(ws + WS_SS2)};
#ifndef NO_G3
        pg8::gemm_phase<pg8::EpiStore<true, D, false>>(lds, g, S, E);
#endif
    }
    GRID_BAR();
    PB_END(9);
    PB_BEGIN(10);
    phase10(p, gw, NGW, lane);
    PB_END(10);
#ifdef PROBE_K
    if (blockIdx.x == 0 && tid == 0) { const unsigned long long t0 = __builtin_amdgcn_s_memrealtime(); while (__builtin_amdgcn_s_memrealtime() - t0 < 3ull * pb_acc) __builtin_amdgcn_s_sleep(8); }
#endif
}

extern "C" void kernel_launch(void* const* d_in, const int* in_sizes, int n_in, void* d_out, int out_size, void* d_ws, size_t ws_size, hipStream_t stream) {
    static int grid = 0;
    if (grid == 0) {
        if (n_in != 20 || in_sizes[0] != M * D || out_size != M * D || ws_size < WS_END) {
            fprintf(stderr, "kernel_launch: unexpected shapes (n_in %d, in0 %d, out %d, ws %zu; need ws >= %zu); nothing launched\n", n_in, n_in > 0 ? in_sizes[0] : -1, out_size, ws_size, (size_t)WS_END);
            grid = -1; return; }
        int dev = 0, cus = 0, per_cu = 0;
        hipGetDevice(&dev);
        hipDeviceGetAttribute(&cus, hipDeviceAttributeMultiprocessorCount, dev);
        if (hipFuncSetAttribute((const void*)mk_fwd, hipFuncAttributeMaxDynamicSharedMemorySize, LDS_BYTES) != hipSuccess) { fprintf(stderr, "kernel_launch: hipFuncSetAttribute failed\n"); grid = -1; return; }
        if (hipOccupancyMaxActiveBlocksPerMultiprocessor(&per_cu, (const void*)mk_fwd, NT, LDS_BYTES) != hipSuccess || per_cu < 1) { fprintf(stderr, "kernel_launch: occupancy query says %d\n", per_cu); per_cu = 1; }
        (void)hipGetLastError();
        grid = cus * per_cu;
    }
    if (grid < 0) return;
    Params p{};
    p.x = (const float*)d_in[0]; p.c = (const float*)d_in[1]; p.ctx = (const float*)d_in[2]; p.c_ctx = (const float*)d_in[3];
    p.w_ada = (const float*)d_in[4]; p.b_ada = (const float*)d_in[5]; p.g_pre_mix = (const float*)d_in[6]; p.g_post_mix = (const float*)d_in[7];
    p.g_pre_ffn = (const float*)d_in[8]; p.g_post_ffn = (const float*)d_in[9]; p.w_in = (const float*)d_in[10]; p.rpb = (const float*)d_in[11];
    p.w_short_conv = (const float*)d_in[12]; p.w_branch_attn = (const float*)d_in[13]; p.w_branch_conv = (const float*)d_in[14]; p.w_out = (const float*)d_in[15];
    p.w_up = (const float*)d_in[16]; p.w_ffn_conv = (const float*)d_in[17]; p.b_ffn_conv = (const float*)d_in[18]; p.w_down = (const float*)d_in[19];
    p.out = (float*)d_out; p.ws = (unsigned char*)d_ws;
    (void)hipMemsetAsync((char*)d_ws + WS_BAR, 0, 16384, stream);
    void* args[] = {&p};
    hipError_t e = hipLaunchCooperativeKernel((const void*)mk_fwd, dim3(grid), dim3(NT), args, LDS_BYTES, stream);
    if (e != hipSuccess) fprintf(stderr, "kernel_launch: cooperative launch failed: %s (grid %d)\n", hipGetErrorString(e), grid);
}
```

```cpp
#include <hip/hip_runtime.h>
#include <hip/hip_cooperative_groups.h>
#include <cstdio>
#include <cstdint>
namespace cg = cooperative_groups;

#define LAS __attribute__((address_space(3)))
typedef unsigned short bf16_t;
typedef short bf16x8 __attribute__((ext_vector_type(8)));
typedef float f32x4 __attribute__((ext_vector_type(4)));
typedef unsigned u32x4 __attribute__((ext_vector_type(4)));
typedef unsigned u32x2 __attribute__((ext_vector_type(2)));

constexpr int D = 1024, NB = 16, SEQ = 2048, M = NB * SEQ, CTXL = 256, MC = NB * CTXL, MT = M + MC;
constexpr int INW = 5120, DFF = 2816, UPW = 2 * DFF, ATTW = 512, CONVW = 512;
constexpr int NMOD = 6 * D;
constexpr float EPS = 1e-6f;
constexpr float LOG2E = 1.4426950408889634f;
constexpr int NWAVES = 8, NT = NWAVES * 64;
constexpr int LDS_BYTES = 147456;

constexpr size_t MiB = 1u << 20;
constexpr size_t WS_MOD = 0;
constexpr size_t WS_BAR = 512 * 1024;
constexpr size_t WS_SS1 = 1 * MiB;
constexpr size_t WS_SS2 = 3 * MiB;
constexpr size_t WS_WIN = 5 * MiB;
constexpr size_t WS_WCAT = 15 * MiB;
constexpr size_t WS_WO = 17 * MiB;
constexpr size_t WS_WUP = 19 * MiB;
constexpr size_t WS_WDN = 30 * MiB;
constexpr size_t WS_A = 36 * MiB;
constexpr size_t WS_P = 108 * MiB;
constexpr size_t WS_ACT = 108 * MiB;
constexpr size_t WS_SBG = 284 * MiB;
constexpr size_t WS_SBP = 295 * MiB;
constexpr size_t WS_SBA = 306 * MiB;
constexpr size_t WS_B = 428 * MiB;
constexpr size_t WS_VT = WS_B;
constexpr size_t WS_KC = WS_B + 32 * MiB;
constexpr size_t WS_VTC = WS_B + 36 * MiB;
constexpr size_t WS_Z = WS_B;
constexpr size_t WS_H2 = WS_B;
constexpr size_t WS_Y2 = WS_B;
constexpr size_t WS_END = 512 * MiB;

struct Params {
    const float *x, *c, *ctx, *c_ctx, *w_ada, *b_ada, *g_pre_mix, *g_post_mix, *g_pre_ffn, *g_post_ffn, *w_in, *rpb, *w_short_conv,
        *w_branch_attn, *w_branch_conv, *w_out, *w_up, *w_ffn_conv, *b_ffn_conv, *w_down;
    float* out;
    unsigned char* ws;
};

__device__ __forceinline__ unsigned cvt_pk_bf16(float lo, float hi) { unsigned r; asm volatile("v_cvt_pk_bf16_f32 %0, %1, %2" : "=v"(r) : "v"(lo), "v"(hi)); return r; }
__device__ __forceinline__ float bf_lo(unsigned w) { return __builtin_bit_cast(float, w << 16); }
__device__ __forceinline__ float bf_hi(unsigned w) { return __builtin_bit_cast(float, w & 0xffff0000u); }
__device__ __forceinline__ float fast_exp2(float x) { return __builtin_amdgcn_exp2f(x); }
__device__ __forceinline__ float fast_rcp(float x) { return __builtin_amdgcn_rcpf(x); }
__device__ __forceinline__ float sigmoidf_(float x) { return fast_rcp(1.0f + fast_exp2(-LOG2E * x)); }
#define LDS_WAIT() asm volatile("s_waitcnt lgkmcnt(0)" ::: "memory")
__device__ __forceinline__ void swap16(float x, float& a, float& b) { a = x; b = x; asm volatile("s_nop 1\n\tv_permlane16_swap_b32 %0, %1" : "+v"(a), "+v"(b)); }
__device__ __forceinline__ void swap32(float x, float& a, float& b) { a = x; b = x; asm volatile("s_nop 1\n\tv_permlane32_swap_b32 %0, %1" : "+v"(a), "+v"(b)); }
__device__ __forceinline__ float max_x16_x32(float x) { float a, b; swap16(x, a, b); x = fmaxf(a, b); swap32(x, a, b); return fmaxf(a, b); }
__device__ __forceinline__ float sum_x16_x32(float x) { float a, b; swap16(x, a, b); x = a + b; swap32(x, a, b); return a + b; }
template <int CTRL> __device__ __forceinline__ float dpp_f(float v) { return __builtin_bit_cast(float, __builtin_amdgcn_update_dpp(0, __builtin_bit_cast(int, v), CTRL, 0xf, 0xf, false)); }
__device__ __forceinline__ float wave_sum(float v) {
    v += dpp_f<0xB1>(v);
    v += dpp_f<0x4E>(v);
    v += dpp_f<0x124>(v);
    v += dpp_f<0x128>(v);
    return sum_x16_x32(v);
}
__device__ __forceinline__ float row16_sum(float v) { v += dpp_f<0xB1>(v); v += dpp_f<0x4E>(v); v += dpp_f<0x124>(v); v += dpp_f<0x128>(v); return v; }

namespace pg8 {
constexpr int BM = 256, BK = 64, HALF = 128, HTB = HALF * BK * 2, STAGE_BYTES = 8 * HTB, NXCD = 8, WGM = 4;
__host__ __device__ __forceinline__ int lds_byte(int r, int c) { const int st = (r >> 4) * 2 + (c >> 5), rr = r & 15, cc = c & 31, ob = rr * 64 + cc * 2; return st * 1024 + (ob ^ (((ob >> 9) & 1) << 5)); }
__host__ __device__ __forceinline__ void stage_rc(int b, int& R, int& C) { const int st = b / 1024, sb = b % 1024, swz = sb ^ (((sb >> 9) & 1) << 5); R = (st >> 1) * 16 + swz / 64; C = (st & 1) * 32 + (swz % 64) / 2; }
__host__ __device__ __forceinline__ int perm32(int rho) { const int n = rho >> 4, i = rho & 15; return 8 * (i >> 2) + 4 * n + (i & 3); }

struct Unit { int pm, pn; };
struct Gemm { const bf16_t* A; const bf16_t* Bt; int lda, K; };

struct Order {
    int nM, nN, nwg, G, c, extra;
    __device__ void init(int nM_, int nN_, int G_, int c_, int extra_) { nM = nM_; nN = nN_; nwg = nM * nN; G = G_; c = c_; extra = extra_; }
    __device__ bool next(int i, Unit& u) const {
        const long L = (long)i * G + c;
        if (L >= nwg) { const int e = (int)(L - nwg); if (e >= extra) return false; u.pm = nM + (e >> 2); u.pn = 2 + (e & 3); return true; }
        int wgid = (int)L; { const int q = nwg / NXCD, r = nwg % NXCD, xcd = wgid % NXCD, off = wgid / NXCD; wgid = (xcd < r ? xcd * (q + 1) : r * (q + 1) + (xcd - r) * q) + off; }
        const int nig = WGM * nN, gid = wgid / nig, fm = gid * WGM, gsz = (nM - fm) < WGM ? (nM - fm) : WGM;
        u.pm = fm + ((wgid % nig) % gsz); u.pn = (wgid % nig) / gsz; return true;
    }
};

template <class Epi>
__device__ __forceinline__ void gemm_phase(LAS unsigned char* lds, const Gemm g, const Order& S, const Epi& E) {
    int tid = threadIdx.x; asm volatile("" : "+v"(tid));
    const int wid = __builtin_amdgcn_readfirstlane(tid >> 6), lane = tid & 63, wr = wid >> 2, wc = wid & 3, fr = lane & 15, fq = lane >> 4;
    const int K = g.K, nt = K / BK, lda = g.lda;
    unsigned voffA[2], voffB[2];
#pragma unroll
    for (int i = 0; i < 2; ++i) { int R, C; stage_rc(tid * 16 + i * 8192, R, C); const int Rb = Epi::PERM ? ((R & ~31) + perm32(R & 31)) : R;
        voffA[i] = (unsigned)(R * lda + C) * 2u; voffB[i] = (unsigned)(Rb * K + C) * 2u; }
    const size_t kstep = (size_t)(BK * 2);
    const size_t hstepA = (size_t)HALF * lda * 2, hstepB = (size_t)HALF * K * 2;
    const size_t tstepA = 2 * hstepA, tstepB = 2 * hstepB;
    const unsigned ldsw = (unsigned)wid * 1024u;
    const int aoff = lds_byte(wr * 64 + fr, fq * 8), boff = lds_byte(wc * 32 + fr, fq * 8);
#define PG8_SA(b, h) (((b) * 2 + (h)) * HTB)
#define PG8_SB(b, h) ((4 + (b) * 2 + (h)) * HTB)
#define PG8_STAGE(bufoff, gbase, voff) do { _Pragma("unroll") for (int _i = 0; _i < 2; ++_i) \
        __builtin_amdgcn_global_load_lds((const unsigned*)((const char*)(gbase) + (voff)[_i]), (LAS unsigned*)(lds + (bufoff) + ldsw + _i * 8192), 16, 0, 0); } while (0)
#define PG8_LDA(dst, b, h) do { _Pragma("unroll") for (int m = 0; m < 4; ++m) _Pragma("unroll") for (int k = 0; k < 2; ++k) dst[m][k] = *(const LAS bf16x8*)(lds + PG8_SA(b, h) + aoff + m * 2048 + k * 1024); } while (0)
#define PG8_LDB(dst, b, h) do { _Pragma("unroll") for (int n = 0; n < 2; ++n) _Pragma("unroll") for (int k = 0; k < 2; ++k) dst[n][k] = *(const LAS bf16x8*)(lds + PG8_SB(b, h) + boff + n * 2048 + k * 1024); } while (0)
#define PG8_MMA(ai, bj, At, Bt) do { __builtin_amdgcn_s_setprio(1); _Pragma("unroll") for (int m = 0; m < 4; ++m) _Pragma("unroll") for (int n = 0; n < 2; ++n) _Pragma("unroll") for (int k = 0; k < 2; ++k) \
        acc[ai][bj][m][n] = __builtin_amdgcn_mfma_f32_16x16x32_bf16(Bt[n][k], At[m][k], acc[ai][bj][m][n], 0, 0, 0); __builtin_amdgcn_s_setprio(0); } while (0)
#define PG8_WAIT_V(n) asm volatile("s_waitcnt vmcnt(" #n ")" ::: "memory")
#define PG8_WAIT_L(n) asm volatile("s_waitcnt lgkmcnt(" #n ")" ::: "memory")
#define PG8_BAR __builtin_amdgcn_s_barrier()
#define PG8_SCHED __builtin_amdgcn_sched_barrier(0)
    Unit cur, nxt; int ui = 0;
    if (!S.next(0, cur)) return;
    f32x4 acc[2][2][4][2];
#pragma unroll
    for (int a = 0; a < 2; ++a)
#pragma unroll
        for (int b = 0; b < 2; ++b)
#pragma unroll
            for (int m = 0; m < 4; ++m)
#pragma unroll
                for (int n = 0; n < 2; ++n) acc[a][b][m][n] = (f32x4){0.f, 0.f, 0.f, 0.f};
    bf16x8 At[4][2], B0[2][2], B1[2][2];
    const char* cA = (const char*)g.A + (size_t)cur.pm * tstepA; const char* cB = (const char*)g.Bt + (size_t)cur.pn * tstepB;
    PG8_STAGE(PG8_SB(0, 0), cB, voffB); PG8_STAGE(PG8_SB(0, 1), cB + hstepB, voffB); PG8_STAGE(PG8_SA(0, 0), cA, voffA); PG8_STAGE(PG8_SA(0, 1), cA + hstepA, voffA);
    if (wr == 1) PG8_BAR;
    PG8_WAIT_V(2); PG8_BAR;
    PG8_STAGE(PG8_SB(1, 0), cB + kstep, voffB); PG8_STAGE(PG8_SA(1, 0), cA + kstep, voffA); PG8_STAGE(PG8_SB(1, 1), cB + hstepB + kstep, voffB);
    PG8_WAIT_V(6); PG8_BAR;
    for (;;) {
        const bool has_next = S.next(ui + 1, nxt);
        const char* nA = has_next ? (const char*)g.A + (size_t)nxt.pm * tstepA : cA; const char* nB = has_next ? (const char*)g.Bt + (size_t)nxt.pn * tstepB : cB;
        for (int th = 0; th < (Epi::MID ? 2 : 1); ++th) {
        const int tb = Epi::MID ? th * Epi::MID_T : 0, te = (Epi::MID && th == 0) ? Epi::MID_T : nt;
        for (int t = tb; t < te; t += 2) {
            const bool last = (t == nt - 2);
            const char* a1 = cA + (size_t)(t + 1) * kstep;
            const char* a2 = last ? nA : cA + (size_t)(t + 2) * kstep; const char* b2 = last ? nB : cB + (size_t)(t + 2) * kstep;
            const char* a3 = a2 + kstep; const char* b3 = b2 + kstep;
            PG8_LDB(B0, 0, 0); PG8_LDB(B1, 0, 1); PG8_SCHED; PG8_LDA(At, 0, 0); PG8_STAGE(PG8_SA(1, 1), a1 + hstepA, voffA);
            PG8_WAIT_V(8); PG8_WAIT_L(0); PG8_BAR; PG8_MMA(0, 0, At, B0); PG8_MMA(0, 1, At, B1); PG8_BAR; PG8_SCHED;
            PG8_LDA(At, 0, 1); PG8_STAGE(PG8_SB(0, 0), b2, voffB); PG8_STAGE(PG8_SB(0, 1), b2 + hstepB, voffB); PG8_STAGE(PG8_SA(0, 0), a2, voffA);
            PG8_WAIT_V(8); PG8_WAIT_L(0); PG8_BAR; PG8_MMA(1, 0, At, B0); PG8_MMA(1, 1, At, B1); PG8_BAR; PG8_SCHED;
            PG8_LDB(B0, 1, 0); PG8_LDB(B1, 1, 1); PG8_SCHED; PG8_LDA(At, 1, 0); PG8_STAGE(PG8_SA(0, 1), a2 + hstepA, voffA);
            PG8_WAIT_V(8); PG8_WAIT_L(0); PG8_BAR; PG8_MMA(0, 0, At, B0); PG8_MMA(0, 1, At, B1); PG8_BAR; PG8_SCHED;
            PG8_LDA(At, 1, 1); PG8_STAGE(PG8_SB(1, 0), b3, voffB); PG8_STAGE(PG8_SB(1, 1), b3 + hstepB, voffB); PG8_STAGE(PG8_SA(1, 0), a3, voffA);
            PG8_WAIT_V(8); PG8_WAIT_L(0); PG8_BAR; PG8_MMA(1, 0, At, B0); PG8_MMA(1, 1, At, B1); PG8_BAR; PG8_SCHED;
        }
        if constexpr (Epi::MID) { if (th == 0) E.mid(acc, cur, wr, wc, fr, fq); }
        }
        if (wr == 0) PG8_BAR;
        E(acc, cur, wr, wc, fr, fq);
        if (!has_next) break;
#pragma unroll
        for (int a = 0; a < 2; ++a)
#pragma unroll
            for (int b = 0; b < 2; ++b)
#pragma unroll
                for (int m = 0; m < 4; ++m)
#pragma unroll
                    for (int n = 0; n < 2; ++n) acc[a][b][m][n] = (f32x4){0.f, 0.f, 0.f, 0.f};
        cur = nxt; cA = nA; cB = nB; ++ui;
        if (wr == 1) PG8_BAR;
    }
    PG8_WAIT_V(0);
    PG8_BAR;
#undef PG8_SA
#undef PG8_SB
#undef PG8_STAGE
#undef PG8_LDA
#undef PG8_LDB
#undef PG8_MMA
#undef PG8_WAIT_V
#undef PG8_WAIT_L
#undef PG8_BAR
#undef PG8_SCHED
}

typedef f32x4 Acc[2][2][4][2];
__device__ __forceinline__ char* sgpr_launder(const char* p) { char* q = (char*)p; asm volatile("" : "+s"(q)); return q; }
#define GPTR(T, ub, voff) ((T*)(sgpr_launder((const char*)(ub)) + (voff)))
__device__ __forceinline__ u32x4 pack8(const f32x4 v0, const f32x4 v1) { u32x4 w; w.x = cvt_pk_bf16(v0[0], v0[1]); w.y = cvt_pk_bf16(v0[2], v0[3]); w.z = cvt_pk_bf16(v1[0], v1[1]); w.w = cvt_pk_bf16(v1[2], v1[3]); return w; }

struct Epi1 {
    static constexpr bool PERM = true, MID = false; static constexpr int MID_T = 0;
    bf16_t *P, *VT, *Kc, *VTc;
    __device__ __forceinline__ void mid(Acc&, const Unit&, int, int, int, int) const {}
    __device__ __forceinline__ void operator()(const Acc& acc, const Unit& u, int wr, int wc, int fr, int fq) const {
        const bool isctx = u.pm >= (M / BM);
        if (u.pn == 4 || u.pn == 5) {
            if (!isctx) {
                const int row_u = u.pm * BM;
                char* ub = (char*)VT + ((size_t)(row_u >> 11) * 512 * SEQ + (size_t)(u.pn - 4) * 256 * SEQ + (row_u & (SEQ - 1))) * 2;
                const unsigned lo = (unsigned)((wc * 32 + 8 * fq) * SEQ + wr * 64 + fr) * 2u;
#pragma unroll
                for (int ai = 0; ai < 2; ++ai)
#pragma unroll
                    for (int m = 0; m < 4; ++m)
#pragma unroll
                        for (int bj = 0; bj < 2; ++bj)
#pragma unroll
                            for (int n = 0; n < 2; ++n) {
                                const f32x4 v = acc[ai][bj][m][n];
                                const unsigned w0 = cvt_pk_bf16(v[0], v[1]), w1 = cvt_pk_bf16(v[2], v[3]);
                                const int cst = ((bj * HALF + 4 * n) * SEQ + ai * HALF + m * 16) * 2;
                                *GPTR(bf16_t, ub + cst, lo) = (bf16_t)(w0 & 0xffffu); *GPTR(bf16_t, ub + cst + SEQ * 2, lo) = (bf16_t)(w0 >> 16);
                                *GPTR(bf16_t, ub + cst + SEQ * 4, lo) = (bf16_t)(w1 & 0xffffu); *GPTR(bf16_t, ub + cst + SEQ * 6, lo) = (bf16_t)(w1 >> 16);
                            }
            } else {
                const int rc_u = u.pm * BM - M;
                char* ub = (char*)VTc + ((size_t)(rc_u >> 8) * 512 * CTXL + (size_t)(u.pn - 4) * 256 * CTXL) * 2;
                const unsigned lo = (unsigned)((wc * 32 + 8 * fq) * CTXL + wr * 64 + fr) * 2u;
#pragma unroll
                for (int ai = 0; ai < 2; ++ai)
#pragma unroll
                    for (int m = 0; m < 4; ++m)
#pragma unroll
                        for (int bj = 0; bj < 2; ++bj)
#pragma unroll
                            for (int n = 0; n < 2; ++n) {
                                const f32x4 v = acc[ai][bj][m][n];
                                const unsigned w0 = cvt_pk_bf16(v[0], v[1]), w1 = cvt_pk_bf16(v[2], v[3]);
                                const int cst = ((bj * HALF + 4 * n) * CTXL + ai * HALF + m * 16) * 2;
                                *GPTR(bf16_t, ub + cst, lo) = (bf16_t)(w0 & 0xffffu); *GPTR(bf16_t, ub + cst + CTXL * 2, lo) = (bf16_t)(w0 >> 16);
                                *GPTR(bf16_t, ub + cst + CTXL * 4, lo) = (bf16_t)(w1 & 0xffffu); *GPTR(bf16_t, ub + cst + CTXL * 6, lo) = (bf16_t)(w1 >> 16);
                            }
            }
        } else if (isctx) {
            char* ub = (char*)Kc + ((size_t)(u.pm * BM - M) * 512 + (size_t)(u.pn * BM - 512)) * 2;
            const unsigned lo = (unsigned)((wr * 64 + fr) * 512 + wc * 32 + 8 * fq) * 2u;
#pragma unroll
            for (int ai = 0; ai < 2; ++ai)
#pragma unroll
                for (int m = 0; m < 4; ++m)
#pragma unroll
                    for (int bj = 0; bj < 2; ++bj)
                        *GPTR(u32x4, ub + ((ai * HALF + m * 16) * 512 + bj * HALF) * 2, lo) = pack8(acc[ai][bj][m][0], acc[ai][bj][m][1]);
        } else if (u.pn >= 12) {
            char* ub = (char*)P + ((size_t)u.pm * BM * INW + 3072 + (size_t)(u.pn - 12) * 128) * 2;
            const unsigned lo = (unsigned)((wr * 64 + fr) * INW + wc * 32 + 8 * fq) * 2u;
#pragma unroll
            for (int ai = 0; ai < 2; ++ai)
#pragma unroll
                for (int m = 0; m < 4; ++m) {
                    f32x4 r0v, r1v, s0v, s1v;
#pragma unroll
                    for (int j = 0; j < 4; ++j) {
                        const float ea0 = fast_exp2(fminf(-LOG2E * acc[ai][0][m][0][j], 60.f)), eb0 = fast_exp2(fminf(-LOG2E * acc[ai][1][m][0][j], 60.f));
                        const float ea1 = fast_exp2(fminf(-LOG2E * acc[ai][0][m][1][j], 60.f)), eb1 = fast_exp2(fminf(-LOG2E * acc[ai][1][m][1][j], 60.f));
                        s0v[j] = fast_rcp(1.0f + eb0); s1v[j] = fast_rcp(1.0f + eb1);
                        r0v[j] = (1.0f + eb0) * fast_rcp(1.0f + ea0); r1v[j] = (1.0f + eb1) * fast_rcp(1.0f + ea1);
                    }
                    __builtin_nontemporal_store(pack8(r0v, r1v), GPTR(u32x4, ub + ((ai * HALF + m * 16) * INW) * 2, lo));
                    __builtin_nontemporal_store(pack8(s0v, s1v), GPTR(u32x4, ub + ((ai * HALF + m * 16) * INW + 1024) * 2, lo));
                }
        } else if (u.pn >= 8) {
            char* ub = (char*)P + ((size_t)u.pm * BM * INW + 2048 + (size_t)(u.pn - 8) * 128) * 2;
            const unsigned lo = (unsigned)((wr * 64 + fr) * INW + wc * 32 + 8 * fq) * 2u;
#pragma unroll
            for (int ai = 0; ai < 2; ++ai)
#pragma unroll
                for (int m = 0; m < 4; ++m)
                    __builtin_nontemporal_store(pack8(acc[ai][0][m][0] * acc[ai][1][m][0], acc[ai][0][m][1] * acc[ai][1][m][1]), GPTR(u32x4, ub + ((ai * HALF + m * 16) * INW) * 2, lo));
        } else {
            char* ub = (char*)P + ((size_t)u.pm * BM * INW + (size_t)u.pn * BM) * 2;
            const unsigned lo = (unsigned)((wr * 64 + fr) * INW + wc * 32 + 8 * fq) * 2u;
#pragma unroll
            for (int ai = 0; ai < 2; ++ai)
#pragma unroll
                for (int m = 0; m < 4; ++m)
#pragma unroll
                    for (int bj = 0; bj < 2; ++bj)
                        __builtin_nontemporal_store(pack8(acc[ai][bj][m][0], acc[ai][bj][m][1]), GPTR(u32x4, ub + ((ai * HALF + m * 16) * INW + bj * HALF) * 2, lo));
        }
    }
};

struct Epi2 {
    static constexpr bool PERM = true, MID = true; static constexpr int MID_T = 8;
    const bf16_t* P; bf16_t* Z;
    __device__ __forceinline__ void mid(Acc& acc, const Unit& u, int wr, int wc, int fr, int fq) const {
        const char* ub = (const char*)P + ((size_t)u.pm * BM * INW + (size_t)u.pn * BM + 3072) * 2;
        const unsigned lo = (unsigned)((wr * 64 + fr) * INW + wc * 32 + 8 * fq) * 2u;
        u32x4 rr[2][4][2];
#pragma unroll
        for (int ai = 0; ai < 2; ++ai)
#pragma unroll
            for (int m = 0; m < 4; ++m)
#pragma unroll
                for (int bj = 0; bj < 2; ++bj) rr[ai][m][bj] = *GPTR(const u32x4, ub + ((ai * HALF + m * 16) * INW + bj * HALF) * 2, lo);
#pragma unroll
        for (int ai = 0; ai < 2; ++ai)
#pragma unroll
            for (int m = 0; m < 4; ++m)
#pragma unroll
                for (int bj = 0; bj < 2; ++bj) {
                    const u32x4 a = rr[ai][m][bj];
                    acc[ai][bj][m][0] *= (f32x4){bf_lo(a.x), bf_hi(a.x), bf_lo(a.y), bf_hi(a.y)};
                    acc[ai][bj][m][1] *= (f32x4){bf_lo(a.z), bf_hi(a.z), bf_lo(a.w), bf_hi(a.w)};
                }
    }
    __device__ __forceinline__ void operator()(const Acc& acc, const Unit& u, int wr, int wc, int fr, int fq) const {
        const char* ub = (const char*)P + ((size_t)u.pm * BM * INW + (size_t)u.pn * BM + 4096) * 2;
        const unsigned lo = (unsigned)((wr * 64 + fr) * INW + wc * 32 + 8 * fq) * 2u;
        char* zb = (char*)Z + ((size_t)u.pm * BM * D + (size_t)u.pn * BM) * 2;
        const unsigned zlo = (unsigned)((wr * 64 + fr) * D + wc * 32 + 8 * fq) * 2u;
        u32x4 gb[2][4][2];
#pragma unroll
        for (int ai = 0; ai < 2; ++ai)
#pragma unroll
            for (int m = 0; m < 4; ++m)
#pragma unroll
                for (int bj = 0; bj < 2; ++bj) gb[ai][m][bj] = *GPTR(const u32x4, ub + ((ai * HALF + m * 16) * INW + bj * HALF) * 2, lo);
#pragma unroll
        for (int ai = 0; ai < 2; ++ai)
#pragma unroll
            for (int m = 0; m < 4; ++m)
#pragma unroll
                for (int bj = 0; bj < 2; ++bj) {
                    const u32x4 b = gb[ai][m][bj];
                    const f32x4 v0 = acc[ai][bj][m][0], v1 = acc[ai][bj][m][1];
                    u32x4 w; w.x = cvt_pk_bf16(v0[0] * bf_lo(b.x), v0[1] * bf_hi(b.x)); w.y = cvt_pk_bf16(v0[2] * bf_lo(b.y), v0[3] * bf_hi(b.y));
                    w.z = cvt_pk_bf16(v1[0] * bf_lo(b.z), v1[1] * bf_hi(b.z)); w.w = cvt_pk_bf16(v1[2] * bf_lo(b.w), v1[3] * bf_hi(b.w));
                    *GPTR(u32x4, zb + ((ai * HALF + m * 16) * D + bj * HALF) * 2, zlo) = w;
                }
    }
};

template <bool SS, int LDC, bool NT = true> struct EpiStore {
    static constexpr bool PERM = true, MID = false; static constexpr int MID_T = 0;
    bf16_t* O; float* ssp;
    __device__ __forceinline__ void mid(Acc&, const Unit&, int, int, int, int) const {}
    __device__ __forceinline__ void operator()(const Acc& acc, const Unit& u, int wr, int wc, int fr, int fq) const {
        char* ub = (char*)O + ((size_t)u.pm * BM * LDC + (size_t)u.pn * BM) * 2;
        const unsigned lo = (unsigned)((wr * 64 + fr) * LDC + wc * 32 + 8 * fq) * 2u;
        char* sb = (char*)ssp + ((size_t)u.pm * BM * 16 + (size_t)u.pn * 4) * 4;
        const unsigned slo = (unsigned)((wr * 64 + fr) * 16 + wc) * 4u;
#pragma unroll
        for (int ai = 0; ai < 2; ++ai)
#pragma unroll
            for (int m = 0; m < 4; ++m) {
                float s = 0.f;
#pragma unroll
                for (int bj = 0; bj < 2; ++bj) { const f32x4 v0 = acc[ai][bj][m][0], v1 = acc[ai][bj][m][1];
                    if (SS) s += (v0[0] * v0[0] + v0[1] * v0[1]) + (v0[2] * v0[2] + v0[3] * v0[3]) + (v1[0] * v1[0] + v1[1] * v1[1]) + (v1[2] * v1[2] + v1[3] * v1[3]);
                    if (NT) __builtin_nontemporal_store(pack8(v0, v1), GPTR(u32x4, ub + ((ai * HALF + m * 16) * LDC + bj * HALF) * 2, lo)); else *GPTR(u32x4, ub + ((ai * HALF + m * 16) * LDC + bj * HALF) * 2, lo) = pack8(v0, v1); }
                if (SS) { s += __shfl_xor(s, 16); s += __shfl_xor(s, 32); if (fq == 0) *GPTR(float, sb + (ai * HALF + m * 16) * 16 * 4, slo) = s; }
            }
    }
};
template <int CTRL> __device__ __forceinline__ float dpp_rot(float v) { return __builtin_bit_cast(float, __builtin_amdgcn_update_dpp(0, __builtin_bit_cast(int, v), CTRL, 0xf, 0xf, false)); }
__device__ __forceinline__ float gelu_tanh_f(float v) {
    const float u = v * (v * v * 0.044715f + 1.0f);
    return v * fast_rcp(1.0f + fast_exp2(u * (-1.5957691216057308f * LOG2E)));
}
struct EpiAct {
    static constexpr bool PERM = true, MID = false; static constexpr int MID_T = 0;
    bf16_t* ACT; float *SBG, *SBP, *SBA; const float *wconv, *bconv;
    __device__ __forceinline__ void mid(Acc&, const Unit&, int, int, int, int) const {}
    __device__ __forceinline__ void operator()(const Acc& acc, const Unit& u, int wr, int wc, int fr, int fq) const {
        const int ch0 = u.pn * 128 + wc * 32 + 8 * fq;
        f32x4 w0[2], w1[2], w2[2], bc[2];
#pragma unroll
        for (int n = 0; n < 2; ++n) { w0[n] = *(const f32x4*)(wconv + ch0 + 4 * n); w1[n] = *(const f32x4*)(wconv + DFF + ch0 + 4 * n); w2[n] = *(const f32x4*)(wconv + 2 * DFF + ch0 + 4 * n); bc[n] = *(const f32x4*)(bconv + ch0 + 4 * n); }
        char* ub = (char*)ACT + ((size_t)u.pm * BM * DFF + (size_t)u.pn * 128) * 2;
        const unsigned lo = (unsigned)((wr * 64 + fr) * DFF + wc * 32 + 8 * fq) * 2u;
        const bool first = fr == 0, lastl = fr == 15;
#pragma unroll
        for (int ai = 0; ai < 2; ++ai) {
            const int blk = u.pm * 4 + ai * 2 + wr;
            f32x4 Rp[2], Lc[2];
#pragma unroll
            for (int n = 0; n < 2; ++n)
#pragma unroll
                for (int e = 0; e < 4; ++e) { Rp[n][e] = 0.f; Lc[n][e] = dpp_rot<0x12F>(acc[ai][1][0][n][e]); }
#pragma unroll
            for (int m = 0; m < 4; ++m) {
                f32x4 act[2], Rc[2], Ln[2];
#pragma unroll
                for (int n = 0; n < 2; ++n)
#pragma unroll
                    for (int e = 0; e < 4; ++e) { Rc[n][e] = dpp_rot<0x121>(acc[ai][1][m][n][e]); Ln[n][e] = m < 3 ? dpp_rot<0x12F>(acc[ai][1][m < 3 ? m + 1 : 3][n][e]) : 0.f; }
#pragma unroll
                for (int n = 0; n < 2; ++n) {
                    const f32x4 g = acc[ai][1][m][n], a = acc[ai][0][m][n];
                    f32x4 prev, next;
#pragma unroll
                    for (int e = 0; e < 4; ++e) { prev[e] = first ? Rp[n][e] : Rc[n][e]; next[e] = lastl ? Ln[n][e] : Lc[n][e]; }
                    const f32x4 cv = w0[n] * prev + w1[n] * g + w2[n] * next + bc[n];
                    if (m == 0) { if (first) { const size_t o = ((size_t)blk * 2 + 0) * DFF + ch0 + 4 * n; *(f32x4*)(SBG + o) = g; *(f32x4*)(SBP + o) = cv; *(f32x4*)(SBA + o) = a; } }
                    if (m == 3) { if (lastl) { const size_t o = ((size_t)blk * 2 + 1) * DFF + ch0 + 4 * n; *(f32x4*)(SBG + o) = g; *(f32x4*)(SBP + o) = cv; *(f32x4*)(SBA + o) = a; } }
#pragma unroll
                    for (int e = 0; e < 4; ++e) act[n][e] = gelu_tanh_f(cv[e]) * a[e];
                }
                __builtin_nontemporal_store(pack8(act[0], act[1]), GPTR(u32x4, ub + (ai * HALF + m * 16) * DFF * 2, lo));
#pragma unroll
                for (int n = 0; n < 2; ++n) { Rp[n] = Rc[n]; Lc[n] = Ln[n]; }
            }
        }
    }
};
}

template <int MAP>
__device__ __forceinline__ void p0_transpose_item(const float* W, int N, bf16_t* WT, int ldt, int koff, int qlim, float qscale, LAS float* scr, int item, int lane) {
    const int nblk = N / 32, kb = item / nblk, nb = item % nblk, k0 = 64 * kb, n0 = 32 * nb;
    const int r0 = MAP == 1 ? (n0 < DFF ? (n0 / 128) * 256 + (n0 % 128) : ((n0 - DFF) / 128) * 256 + 128 + ((n0 - DFF) % 128))
                 : (MAP == 2 && n0 >= 3072) ? (n0 < 4096 ? 3072 + ((n0 - 3072) / 128) * 256 + ((n0 - 3072) % 128) : 3072 + ((n0 - 4096) / 128) * 256 + 128 + ((n0 - 4096) % 128))
                 : (MAP == 2 && n0 >= 2048) ? (n0 < 2560 ? 2048 + ((n0 - 2048) / 128) * 256 + ((n0 - 2048) % 128) : 2048 + ((n0 - 2560) / 128) * 256 + 128 + ((n0 - 2560) % 128)) : n0;
    float tv[32];
#pragma unroll
    for (int i = 0; i < 32; ++i) tv[i] = __builtin_nontemporal_load(W + (size_t)(k0 + 2 * i + (lane >> 5)) * N + n0 + (lane & 31));
#pragma unroll
    for (int i = 0; i < 32; ++i) scr[(2 * i + (lane >> 5)) * 33 + (lane & 31)] = tv[i];
    LDS_WAIT(); asm volatile("" ::: "memory");
    const int c = lane & 7;
#pragma unroll
    for (int j = 0; j < 4; ++j) { const int n = (lane >> 3) + 8 * j; const LAS float* s = scr + (8 * c) * 33 + n;
        const float sc = (n0 + n) < qlim ? qscale : 1.0f;
        u32x4 o; o.x = cvt_pk_bf16(s[0 * 33] * sc, s[1 * 33] * sc); o.y = cvt_pk_bf16(s[2 * 33] * sc, s[3 * 33] * sc); o.z = cvt_pk_bf16(s[4 * 33] * sc, s[5 * 33] * sc); o.w = cvt_pk_bf16(s[6 * 33] * sc, s[7 * 33] * sc);
        *(u32x4*)(WT + (size_t)(r0 + n) * ldt + koff + k0 + 8 * c) = o; }
    LDS_WAIT(); asm volatile("" ::: "memory");
}

__device__ __forceinline__ void phase0(const Params& p, LAS unsigned char* lds, int gw, int NGW, int wave, int lane) {
    unsigned char* ws = p.ws;
    LAS float* sl = (LAS float*)lds;
    {
        float cv[34];
#pragma unroll
        for (int k = 0; k < 34; ++k) { const int i = threadIdx.x + k * NT; cv[k] = i < 16 * D ? p.c[i] : p.c_ctx[i - 16 * D]; }
#pragma unroll
        for (int k = 0; k < 34; ++k) sl[threadIdx.x + k * NT] = cv[k] * sigmoidf_(cv[k]);
    }
    __syncthreads();
    {
        const int nit = NMOD / 16;
        float* mod = (float*)(ws + WS_MOD);
        LAS float* red = (LAS float*)(lds + 17 * D * 4);
        for (int it = blockIdx.x; it < nit; it += gridDim.x) {
            const int kg = lane >> 2, cq = lane & 3, col = it * 16 + cq * 4;
            f32x4 a[17];
#pragma unroll
            for (int b = 0; b < 17; ++b) a[b] = (f32x4){0.f, 0.f, 0.f, 0.f};
            f32x4 w[8];
#pragma unroll
            for (int i = 0; i < 8; ++i) w[i] = __builtin_nontemporal_load((const f32x4*)(p.w_ada + (size_t)(i * 128 + wave * 16 + kg) * NMOD + col));
#pragma unroll
            for (int i = 0; i < 8; ++i) {
                const int k = i * 128 + wave * 16 + kg;
#pragma unroll
                for (int b = 0; b < 17; ++b) { const float sv = sl[b * D + k]; a[b] += w[i] * sv; }
            }
#pragma unroll
            for (int b = 0; b < 17; ++b)
#pragma unroll
                for (int e = 0; e < 4; ++e) { float v = a[b][e]; v += __shfl_xor(v, 4); v += __shfl_xor(v, 8); v += __shfl_xor(v, 16); v += __shfl_xor(v, 32); a[b][e] = v; }
            if (kg == 0) {
#pragma unroll
                for (int b = 0; b < 17; ++b) *(LAS f32x4*)(red + (wave * 17 + b) * 16 + cq * 4) = a[b]; }
            __syncthreads();
            if (threadIdx.x < 17 * 16) { const int b = threadIdx.x >> 4, cc = threadIdx.x & 15; float v = p.b_ada[it * 16 + cc];
#pragma unroll
                for (int w8 = 0; w8 < 8; ++w8) v += red[(w8 * 17 + b) * 16 + cc];
                mod[(size_t)b * NMOD + it * 16 + cc] = v; }
            __syncthreads();
        }
    }
    LAS float* scr = (LAS float*)(lds + 17 * D * 4 + 8704 + wave * 8448);
    constexpr int I_IN = (D / 64) * (INW / 32), I_BA = (ATTW / 64) * (D / 32), I_BB = (CONVW / 64) * (D / 32), I_O = (D / 64) * (D / 32), I_UP = (D / 64) * (UPW / 32), I_DN = (DFF / 64) * (D / 32);
    constexpr int NITEMS = I_IN + I_BA + I_BB + I_O + I_UP + I_DN;
    for (int it = gw; it < NITEMS; it += NGW) {
        int r = it;
        if (r < I_IN) { p0_transpose_item<2>(p.w_in, INW, (bf16_t*)(ws + WS_WIN), D, 0, 512, 0.125f * LOG2E, scr, r, lane); continue; } r -= I_IN;
        if (r < I_BA) { p0_transpose_item<0>(p.w_branch_attn, D, (bf16_t*)(ws + WS_WCAT), D, 0, 0, 1.f, scr, r, lane); continue; } r -= I_BA;
        if (r < I_BB) { p0_transpose_item<0>(p.w_branch_conv, D, (bf16_t*)(ws + WS_WCAT), D, 512, 0, 1.f, scr, r, lane); continue; } r -= I_BB;
        if (r < I_O) { p0_transpose_item<0>(p.w_out, D, (bf16_t*)(ws + WS_WO), D, 0, 0, 1.f, scr, r, lane); continue; } r -= I_O;
        if (r < I_UP) { p0_transpose_item<1>(p.w_up, UPW, (bf16_t*)(ws + WS_WUP), D, 0, 0, 1.f, scr, r, lane); continue; } r -= I_UP;
        p0_transpose_item<0>(p.w_down, D, (bf16_t*)(ws + WS_WDN), DFF, 0, 0, 1.f, scr, r, lane);
    }
}

__device__ __forceinline__ void p1_load(const Params& p, int row0, int lane, f32x4 (&v)[2][4]) {
#pragma unroll
    for (int r = 0; r < 2; ++r) { const int row = row0 + r; const float* xr = row < M ? p.x + (size_t)row * D : p.ctx + (size_t)(row - M) * D;
#pragma unroll
        for (int j = 0; j < 4; ++j) v[r][j] = __builtin_nontemporal_load((const f32x4*)(xr + 4 * lane + 256 * j)); }
}
__device__ __forceinline__ void phase1(const Params& p, int gw, int NGW, int lane) {
    const float* mod = (const float*)(p.ws + WS_MOD);
    bf16_t* H = (bf16_t*)(p.ws + WS_A);
    f32x4 v[2][4], vn[2][4];
    f32x4 gq[4];
#pragma unroll
    for (int j = 0; j < 4; ++j) gq[j] = *(const f32x4*)(p.g_pre_mix + 4 * lane + 256 * j);
    int row0 = gw * 2;
    if (row0 < MT) p1_load(p, row0, lane, v);
    for (; row0 < MT; row0 += NGW * 2) {
        const int nrow = row0 + NGW * 2;
        p1_load(p, nrow < MT ? nrow : row0, lane, vn);
        asm volatile("" ::: "memory"); __builtin_amdgcn_sched_barrier(0);
        float s[2];
#pragma unroll
        for (int r = 0; r < 2; ++r) { s[r] = 0.f;
#pragma unroll
            for (int j = 0; j < 4; ++j) s[r] += (v[r][j][0] * v[r][j][0] + v[r][j][1] * v[r][j][1]) + (v[r][j][2] * v[r][j][2] + v[r][j][3] * v[r][j][3]); }
#pragma unroll
        for (int r = 0; r < 2; ++r) {
            const int row = row0 + r; const int b = row < M ? (row >> 11) : 16;
            const float* md = mod + (size_t)b * NMOD;
            const float rstd = 1.0f / sqrtf(wave_sum(s[r]) * (1.0f / D) + EPS);
#pragma unroll
            for (int j = 0; j < 4; ++j) {
                const int col = 4 * lane + 256 * j;
                const f32x4 g = gq[j], sh = *(const f32x4*)(md + col), sc = *(const f32x4*)(md + D + col);
                f32x4 h = (v[r][j] * rstd) * g; h = h * (sc + 1.0f) + sh;
                u32x2 o; o.x = cvt_pk_bf16(h[0], h[1]); o.y = cvt_pk_bf16(h[2], h[3]);
                *(u32x2*)(H + (size_t)row * D + col) = o;
            }
        }
#pragma unroll
        for (int r = 0; r < 2; ++r)
#pragma unroll
            for (int j = 0; j < 4; ++j) v[r][j] = vn[r][j];
    }
}

struct KV { bf16x8 k[2][2]; bf16x8 v[4]; };

__device__ __forceinline__ void attn_load(KV& f, int c, int nwin, int rlo, int b, int h, int kstart, int fr, int fq,
                                          const bf16_t* P, const bf16_t* VT, const bf16_t* Kc, const bf16_t* VTc) {
    const bf16_t* kb; const bf16_t* vb; int kld, vld;
    if (c < nwin) { const int rr = rlo + c; kb = P + (size_t)(b * SEQ + rr * 64 + kstart) * INW + 512 + 64 * h; kld = INW; vb = VT + (size_t)(b * 512 + 64 * h) * SEQ + rr * 64 + kstart; vld = SEQ; }
    else { const int cc = c - nwin; kb = Kc + (size_t)(b * CTXL + cc * 32) * 512 + 64 * h; kld = 512; vb = VTc + (size_t)(b * 512 + 64 * h) * CTXL + cc * 32; vld = CTXL; }
    const int kr = 8 * (fr >> 2) + (fr & 3);
#pragma unroll
    for (int blk = 0; blk < 2; ++blk)
#pragma unroll
        for (int ds = 0; ds < 2; ++ds) f.k[blk][ds] = *(const bf16x8*)(kb + (size_t)(kr + 4 * blk) * kld + 32 * ds + 8 * fq);
#pragma unroll
    for (int db = 0; db < 4; ++db) f.v[db] = *(const bf16x8*)(vb + (size_t)(16 * db + fr) * vld + 8 * fq);
}

__device__ __forceinline__ void attn_chunk(const KV& cur, int c, int nwin, int rlo, int r0, int h, int dc0, const float (&madd)[8], const LAS float* tab,
                                           const bf16x8 (&qf)[4][2], f32x4 (&o)[4][4], float (&mrun)[4], float (&lrun)[4]) {
    constexpr int TPAD = 32;
    const bool win = c < nwin; const int rr = rlo + c;
#pragma unroll
    for (int qi = 0; qi < 4; ++qi) {
        const int r = r0 + qi, rs = min(max(r - 4, 0), 24);
        if (win && (rr < rs || rr > rs + 7)) continue;
        f32x4 s0 = (f32x4){0.f, 0.f, 0.f, 0.f}, s1 = (f32x4){0.f, 0.f, 0.f, 0.f};
        s0 = __builtin_amdgcn_mfma_f32_16x16x32_bf16(cur.k[0][0], qf[qi][0], s0, 0, 0, 0);
        s0 = __builtin_amdgcn_mfma_f32_16x16x32_bf16(cur.k[0][1], qf[qi][1], s0, 0, 0, 0);
        s1 = __builtin_amdgcn_mfma_f32_16x16x32_bf16(cur.k[1][0], qf[qi][0], s1, 0, 0, 0);
        s1 = __builtin_amdgcn_mfma_f32_16x16x32_bf16(cur.k[1][1], qf[qi][1], s1, 0, 0, 0);
        float sv[8] = {s0[0], s0[1], s0[2], s0[3], s1[0], s1[1], s1[2], s1[3]};
        if (win) {
            const LAS float* bp = tab + TPAD + h * 465 + (rr - r + 7) * 31 + dc0;
            float bv[8];
#pragma unroll
            for (int j = 0; j < 8; ++j) bv[j] = bp[j];
#pragma unroll
            for (int j = 0; j < 8; ++j) sv[j] = (sv[j] + bv[j]) + madd[j];
        }
        float mx = fmaxf(fmaxf(fmaxf(sv[0], sv[1]), fmaxf(sv[2], sv[3])), fmaxf(fmaxf(sv[4], sv[5]), fmaxf(sv[6], sv[7])));
        mx = max_x16_x32(mx);
        const float mn = fmaxf(mrun[qi], mx), alpha = fast_exp2(mrun[qi] - mn);
        mrun[qi] = mn;
        float ps = 0.f;
#pragma unroll
        for (int j = 0; j < 8; ++j) { sv[j] = fast_exp2(sv[j] - mn); ps += sv[j]; }
        lrun[qi] = lrun[qi] * alpha + ps;
        union { bf16x8 v; unsigned w[4]; } pf;
        pf.w[0] = cvt_pk_bf16(sv[0], sv[1]); pf.w[1] = cvt_pk_bf16(sv[2], sv[3]); pf.w[2] = cvt_pk_bf16(sv[4], sv[5]); pf.w[3] = cvt_pk_bf16(sv[6], sv[7]);
#pragma unroll
        for (int db = 0; db < 4; ++db) { o[qi][db] *= alpha; o[qi][db] = __builtin_amdgcn_mfma_f32_16x16x32_bf16(cur.v[db], pf.v, o[qi][db], 0, 0, 0); }
    }
}

__device__ __forceinline__ void phase3(const Params& p, LAS unsigned char* lds, int gw, int NGW, int lane) {
    const bf16_t* P = (const bf16_t*)(p.ws + WS_P); const bf16_t* VT = (const bf16_t*)(p.ws + WS_VT);
    const bf16_t* Kc = (const bf16_t*)(p.ws + WS_KC); const bf16_t* VTc = (const bf16_t*)(p.ws + WS_VTC);
    bf16_t* ATT = (bf16_t*)(p.ws + WS_A);
    constexpr int TPAD = 32, NRPB = 8 * 15 * 31;
    LAS float* tab = (LAS float*)lds;
    {
        float tv[8];
#pragma unroll
        for (int k = 0; k < 8; ++k) { const int j = (int)threadIdx.x + k * NT - TPAD; tv[k] = (j >= 0 && j < NRPB) ? p.rpb[j] * LOG2E : 0.f; }
#pragma unroll
        for (int k = 0; k < 8; ++k) { const int i = (int)threadIdx.x + k * NT; if (i < NRPB + 2 * TPAD + 64) tab[i] = tv[k]; }
    }
    __syncthreads();
    const int fr = lane & 15, fq = lane >> 4;
    for (int item = gw; item < 4096; item += NGW) {
        const int rg = item & 7, n = (item >> 3) & 3, h = (item >> 5) & 7, b = item >> 8;
        const int r0 = rg * 4;
        const int kstart = n == 0 ? 0 : (n == 1 ? 8 : (n == 2 ? 24 : 32));
        const int qcol = 16 * n + fr;
        const int cs = min(max(qcol - 8, 0), 48);
        float madd[8];
#pragma unroll
        for (int j = 0; j < 8; ++j) { const int kc = kstart + 8 * fq + j; madd[j] = (kc >= cs && kc < cs + 16) ? 0.f : -1e30f; }
        const int dc0 = kstart + 8 * fq - qcol + 15;
        const int rlo = min(max(r0 - 4, 0), 24), rhi = min(max(r0 + 3 - 4, 0), 24) + 7;
        const int nwin = rhi - rlo + 1, nch = nwin + 8;
        bf16x8 qf[4][2];
#pragma unroll
        for (int qi = 0; qi < 4; ++qi)
#pragma unroll
            for (int ds = 0; ds < 2; ++ds) qf[qi][ds] = *(const bf16x8*)(P + (size_t)(b * SEQ + (r0 + qi) * 64 + qcol) * INW + 64 * h + 32 * ds + 8 * fq);
        f32x4 o[4][4]; float mrun[4], lrun[4];
#pragma unroll
        for (int qi = 0; qi < 4; ++qi) { mrun[qi] = -1e30f; lrun[qi] = 0.f;
#pragma unroll
            for (int db = 0; db < 4; ++db) o[qi][db] = (f32x4){0.f, 0.f, 0.f, 0.f}; }
        KV ka, kb;
        attn_load(ka, 0, nwin, rlo, b, h, kstart, fr, fq, P, VT, Kc, VTc);
        for (int c = 0; c < nch; c += 2) {
            attn_load(kb, min(c + 1, nch - 1), nwin, rlo, b, h, kstart, fr, fq, P, VT, Kc, VTc);
            asm volatile("" ::: "memory"); __builtin_amdgcn_sched_barrier(0);
            attn_chunk(ka, c, nwin, rlo, r0, h, dc0, madd, tab, qf, o, mrun, lrun);
            asm volatile("" ::: "memory"); __builtin_amdgcn_sched_barrier(0);
            attn_load(ka, min(c + 2, nch - 1), nwin, rlo, b, h, kstart, fr, fq, P, VT, Kc, VTc);
            asm volatile("" ::: "memory"); __builtin_amdgcn_sched_barrier(0);
            if (c + 1 < nch) attn_chunk(kb, c + 1, nwin, rlo, r0, h, dc0, madd, tab, qf, o, mrun, lrun);
            asm volatile("" ::: "memory"); __builtin_amdgcn_sched_barrier(0);
        }
#pragma unroll
        for (int qi = 0; qi < 4; ++qi) {
            const float l = sum_x16_x32(lrun[qi]);
            const float inv = 1.0f / l;
            bf16_t* op = ATT + (size_t)(b * SEQ + (r0 + qi) * 64 + qcol) * D + 64 * h + 4 * fq;
#pragma unroll
            for (int db = 0; db < 4; ++db) { const f32x4 v = o[qi][db] * inv; u32x2 w; w.x = cvt_pk_bf16(v[0], v[1]); w.y = cvt_pk_bf16(v[2], v[3]); *(u32x2*)(op + 16 * db) = w; }
        }
    }
}
__device__ __forceinline__ void phase3b(const Params& p, int gw, int NGW, int lane) {
    const bf16_t* P = (const bf16_t*)(p.ws + WS_P); bf16_t* ATT = (bf16_t*)(p.ws + WS_A);
    {
        const int c8 = lane * 8;
        float w0[8], w1[8], w2[8];
#pragma unroll
        for (int e = 0; e < 8; ++e) { w0[e] = p.w_short_conv[c8 + e]; w1[e] = p.w_short_conv[CONVW + c8 + e]; w2[e] = p.w_short_conv[2 * CONVW + c8 + e]; }
        for (int tok0 = gw; tok0 < M; tok0 += 2 * NGW) {
            u32x4 bg[2], c0[2], c1[2], c2[2];
            const u32x4 z4 = (u32x4){0u, 0u, 0u, 0u};
#pragma unroll
            for (int r = 0; r < 2; ++r) {
                const int tok = tok0 + r * NGW, t = tok & (SEQ - 1);
                const bf16_t* rp = P + (size_t)tok * INW;
                bg[r] = __builtin_nontemporal_load((const u32x4*)(rp + 1536 + c8));
                c1[r] = *(const u32x4*)(rp + 2048 + c8);
                c0[r] = t > 0 ? *(const u32x4*)(rp - INW + 2048 + c8) : z4;
                c2[r] = t < SEQ - 1 ? *(const u32x4*)(rp + INW + 2048 + c8) : z4;
            }
#pragma unroll
            for (int r = 0; r < 2; ++r) {
                const int tok = tok0 + r * NGW;
                u32x4 o;
#pragma unroll
                for (int q = 0; q < 4; ++q) {
                    const float lo = bf_lo(bg[r][q]) * (w0[2 * q] * bf_lo(c0[r][q]) + w1[2 * q] * bf_lo(c1[r][q]) + w2[2 * q] * bf_lo(c2[r][q]));
                    const float hi = bf_hi(bg[r][q]) * (w0[2 * q + 1] * bf_hi(c0[r][q]) + w1[2 * q + 1] * bf_hi(c1[r][q]) + w2[2 * q + 1] * bf_hi(c2[r][q]));
                    o[q] = cvt_pk_bf16(lo, hi);
                }
                *(u32x4*)(ATT + (size_t)tok * D + 512 + c8) = o;
            }
        }
    }
}

__device__ __forceinline__ void p6_load(const Params& p, const bf16_t* Y, const float* ss1, int row0, int lane, f32x4 (&v)[2][4], u32x2 (&yw)[2][4], float (&ps)[2]) {
#pragma unroll
    for (int r = 0; r < 2; ++r) { const int row = row0 + r;
        ps[r] = ss1[(size_t)row * 16 + (lane & 15)];
#pragma unroll
        for (int j = 0; j < 4; ++j) { const int col = 4 * lane + 256 * j; v[r][j] = __builtin_nontemporal_load((const f32x4*)(p.x + (size_t)row * D + col)); yw[r][j] = __builtin_nontemporal_load((const u32x2*)(Y + (size_t)row * D + col)); } }
}
__device__ __forceinline__ void phase6(const Params& p, int gw, int NGW, int lane) {
    const float* mod = (const float*)(p.ws + WS_MOD);
    const bf16_t* Y = (const bf16_t*)(p.ws + WS_A);
    const float* ss1 = (const float*)(p.ws + WS_SS1);
    bf16_t* H2 = (bf16_t*)(p.ws + WS_H2);
    f32x4 v[2][4], vn[2][4]; u32x2 yw[2][4], ywn[2][4]; float ps[2], psn[2];
    f32x4 gq1[4], gq2[4];
#pragma unroll
    for (int j = 0; j < 4; ++j) { gq1[j] = *(const f32x4*)(p.g_post_mix + 4 * lane + 256 * j); gq2[j] = *(const f32x4*)(p.g_pre_ffn + 4 * lane + 256 * j); }
    const bool bm = (NGW == 2048);
    const int rstart = bm ? (gw >> 7) * SEQ + (gw & 127) * 2 : gw * 2, rstep = bm ? 256 : NGW * 2, rend = bm ? (gw >> 7) * SEQ + SEQ : M;
    f32x4 mgt[4], msh[4], msc[4];
    { const float* md0 = mod + (size_t)((rstart < M ? rstart : 0) >> 11) * NMOD;
#pragma unroll
      for (int j = 0; j < 4; ++j) { const int col = 4 * lane + 256 * j; mgt[j] = *(const f32x4*)(md0 + 2 * D + col); msh[j] = *(const f32x4*)(md0 + 3 * D + col); msc[j] = *(const f32x4*)(md0 + 4 * D + col); } }
    int row0 = rstart;
    if (row0 < rend) p6_load(p, Y, ss1, row0, lane, v, yw, ps);
    for (; row0 < rend; row0 += rstep) {
        const int nrow = row0 + rstep;
        p6_load(p, Y, ss1, nrow < rend ? nrow : row0, lane, vn, ywn, psn);
        asm volatile("" ::: "memory"); __builtin_amdgcn_sched_barrier(0);
        float s[2];
#pragma unroll
        for (int r = 0; r < 2; ++r) {
            const int row = row0 + r; const float* md = mod + (size_t)(row >> 11) * NMOD;
            float q = row16_sum(ps[r]);
            const float rstdy = 1.0f / sqrtf(q * (1.0f / D) + EPS);
            s[r] = 0.f;
#pragma unroll
            for (int j = 0; j < 4; ++j) {
                const int col = 4 * lane + 256 * j;
                const f32x4 y = (f32x4){bf_lo(yw[r][j].x), bf_hi(yw[r][j].x), bf_lo(yw[r][j].y), bf_hi(yw[r][j].y)};
                const f32x4 g = gq1[j], gt = bm ? mgt[j] : *(const f32x4*)(md + 2 * D + col);
                v[r][j] = v[r][j] + gt * ((y * rstdy) * g);
                s[r] += (v[r][j][0] * v[r][j][0] + v[r][j][1] * v[r][j][1]) + (v[r][j][2] * v[r][j][2] + v[r][j][3] * v[r][j][3]);
            }
        }
#pragma unroll
        for (int r = 0; r < 2; ++r) {
            const int row = row0 + r; const float* md = mod + (size_t)(row >> 11) * NMOD;
            const float rstd = 1.0f / sqrtf(wave_sum(s[r]) * (1.0f / D) + EPS);
#pragma unroll
            for (int j = 0; j < 4; ++j) {
                const int col = 4 * lane + 256 * j;
                const f32x4 g = gq2[j], sh = bm ? msh[j] : *(const f32x4*)(md + 3 * D + col), sc = bm ? msc[j] : *(const f32x4*)(md + 4 * D + col);
                f32x4 h = (v[r][j] * rstd) * g; h = h * (sc + 1.0f) + sh;
                u32x2 o; o.x = cvt_pk_bf16(h[0], h[1]); o.y = cvt_pk_bf16(h[2], h[3]);
                *(u32x2*)(H2 + (size_t)row * D + col) = o;
            }
        }
#pragma unroll
        for (int r = 0; r < 2; ++r) { ps[r] = psn[r];
#pragma unroll
            for (int j = 0; j < 4; ++j) { v[r][j] = vn[r][j]; yw[r][j] = ywn[r][j]; } }
    }
}

__device__ __forceinline__ void act_fixup_panel(const Params& p, int pm, int tid) {
    bf16_t* ACT = (bf16_t*)(p.ws + WS_ACT);
    const float* SBG = (const float*)(p.ws + WS_SBG); const float* SBP = (const float*)(p.ws + WS_SBP); const float* SBA = (const float*)(p.ws + WS_SBA);
    constexpr int CPR = DFF / 4;
    for (int idx = tid; idx < 8 * CPR; idx += NT) {
        const int k = idx / CPR, c4 = (idx - k * CPR) * 4, bs = pm * 8 + k, blk = bs >> 1, side = bs & 1;
        const int row = blk * 64 + (side ? 63 : 0), t = row & (SEQ - 1);
        const f32x4 part = *(const f32x4*)(SBP + (size_t)bs * DFF + c4), a = *(const f32x4*)(SBA + (size_t)bs * DFF + c4);
        f32x4 gnb = (f32x4){0.f, 0.f, 0.f, 0.f}, w;
        if (side == 0) { w = *(const f32x4*)(p.w_ffn_conv + c4); if (t > 0) gnb = *(const f32x4*)(SBG + (size_t)(bs - 1) * DFF + c4); }
        else { w = *(const f32x4*)(p.w_ffn_conv + 2 * DFF + c4); if (t < SEQ - 1) gnb = *(const f32x4*)(SBG + (size_t)(bs + 1) * DFF + c4); }
        const f32x4 cv = part + w * gnb;
        u32x2 o; o.x = cvt_pk_bf16(pg8::gelu_tanh_f(cv[0]) * a[0], pg8::gelu_tanh_f(cv[1]) * a[1]); o.y = cvt_pk_bf16(pg8::gelu_tanh_f(cv[2]) * a[2], pg8::gelu_tanh_f(cv[3]) * a[3]);
        *(u32x2*)(ACT + (size_t)row * DFF + c4) = o;
    }
}

__device__ __forceinline__ void p10_load(const Params& p, const bf16_t* Y, const bf16_t* Y2, const float* ss1, const float* ss2, int row, int lane, f32x4 (&v)[4], u32x2 (&y1)[4], u32x2 (&y2)[4], float (&ps)[2]) {
    ps[0] = ss1[(size_t)row * 16 + (lane & 15)]; ps[1] = ss2[(size_t)row * 16 + (lane & 15)];
#pragma unroll
    for (int j = 0; j < 4; ++j) { const int col = 4 * lane + 256 * j;
        v[j] = __builtin_nontemporal_load((const f32x4*)(p.x + (size_t)row * D + col));
        y1[j] = __builtin_nontemporal_load((const u32x2*)(Y + (size_t)row * D + col)); y2[j] = __builtin_nontemporal_load((const u32x2*)(Y2 + (size_t)row * D + col)); }
}
__device__ __forceinline__ void phase10(const Params& p, int gw, int NGW, int lane) {
    const float* mod = (const float*)(p.ws + WS_MOD);
    const bf16_t* Y = (const bf16_t*)(p.ws + WS_A); const bf16_t* Y2 = (const bf16_t*)(p.ws + WS_Y2);
    const float* ss1 = (const float*)(p.ws + WS_SS1); const float* ss2 = (const float*)(p.ws + WS_SS2);
    f32x4 v[4], vn[4]; u32x2 y1[4], y1n[4], y2[4], y2n[4]; float ps[2], psn[2];
    f32x4 gq1[4], gq2[4];
#pragma unroll
    for (int j = 0; j < 4; ++j) { gq1[j] = *(const f32x4*)(p.g_post_mix + 4 * lane + 256 * j); gq2[j] = *(const f32x4*)(p.g_post_ffn + 4 * lane + 256 * j); }
    const bool bm = (NGW == 2048);
    const int rstart = bm ? (gw >> 7) * SEQ + (gw & 127) : gw, rstep = bm ? 128 : NGW, rend = bm ? (gw >> 7) * SEQ + SEQ : M;
    f32x4 mt1[4], mt2[4];
    { const float* md0 = mod + (size_t)((rstart < M ? rstart : 0) >> 11) * NMOD;
#pragma unroll
      for (int j = 0; j < 4; ++j) { const int col = 4 * lane + 256 * j; mt1[j] = *(const f32x4*)(md0 + 2 * D + col); mt2[j] = *(const f32x4*)(md0 + 5 * D + col); } }
    int row = rstart;
    if (row < rend) p10_load(p, Y, Y2, ss1, ss2, row, lane, v, y1, y2, ps);
    for (; row < rend; row += rstep) {
        const int nrow = row + rstep;
        p10_load(p, Y, Y2, ss1, ss2, nrow < rend ? nrow : row, lane, vn, y1n, y2n, psn);
        asm volatile("" ::: "memory"); __builtin_amdgcn_sched_barrier(0);
        const float* md = mod + (size_t)(row >> 11) * NMOD;
        float q1 = ps[0], q2 = ps[1];
        q1 = row16_sum(q1); q2 = row16_sum(q2);
        const float r1 = 1.0f / sqrtf(q1 * (1.0f / D) + EPS), r2 = 1.0f / sqrtf(q2 * (1.0f / D) + EPS);
#pragma unroll
        for (int j = 0; j < 4; ++j) {
            const int col = 4 * lane + 256 * j;
            const f32x4 a1 = (f32x4){bf_lo(y1[j].x), bf_hi(y1[j].x), bf_lo(y1[j].y), bf_hi(y1[j].y)};
            const f32x4 a2 = (f32x4){bf_lo(y2[j].x), bf_hi(y2[j].x), bf_lo(y2[j].y), bf_hi(y2[j].y)};
            const f32x4 g1 = gq1[j], t1 = bm ? mt1[j] : *(const f32x4*)(md + 2 * D + col);
            const f32x4 g2 = gq2[j], t2 = bm ? mt2[j] : *(const f32x4*)(md + 5 * D + col);
            const f32x4 x1 = v[j] + t1 * ((a1 * r1) * g1);
            __builtin_nontemporal_store(x1 + t2 * ((a2 * r2) * g2), (f32x4*)(p.out + (size_t)row * D + col));
        }
        ps[0] = psn[0]; ps[1] = psn[1];
#pragma unroll
        for (int j = 0; j < 4; ++j) { v[j] = vn[j]; y1[j] = y1n[j]; y2[j] = y2n[j]; }
    }
}

#define XB_TMO      128
#define XB_XCNT(j)  (256  + 64 * (j))
#define XB_XSUB(j)  (1280 + 64 * (j))
#define XB_XGEN(j)  (2304 + 64 * (j))
#define XB_TOP      3328
#define XB_TOPGEN   3392
#define XCD_BAR_WORDS 3456
#define XB_SPIN_CAP (1u << 18)
__device__ __forceinline__ unsigned xb_ld(unsigned* p)              { return __hip_atomic_load(p, __ATOMIC_RELAXED, __HIP_MEMORY_SCOPE_AGENT); }
__device__ __forceinline__ unsigned xb_add(unsigned* p, unsigned v) { return __hip_atomic_fetch_add(p, v, __ATOMIC_RELAXED, __HIP_MEMORY_SCOPE_AGENT); }
__device__ __forceinline__ unsigned xb_xcc_id() { return (unsigned)__builtin_amdgcn_s_getreg((3 << 11) | 20) & 0xFu; }
#define XB_SPIN(cond, bar) do { unsigned _sp = 0; while (cond) { __builtin_amdgcn_s_sleep(1); \
    if ((++_sp & 255u) == 0u) { if (xb_ld(&(bar)[XB_TMO])) break; if (_sp > XB_SPIN_CAP) { atomicAdd(&(bar)[XB_TMO], 1u); break; } } } } while (0)
struct XcdBarrier { unsigned* bar; unsigned x; volatile LAS unsigned* st; };
__device__ __forceinline__ XcdBarrier xcd_barrier_post(unsigned* bar, volatile LAS unsigned* st) {
    XcdBarrier b; b.bar = bar; b.x = xb_xcc_id(); b.st = st;
    if (threadIdx.x == 0) (void)xb_add(&bar[XB_XCNT(b.x)], 1u);
    return b;
}
__device__ __forceinline__ void xcd_barrier_complete(unsigned* bar, unsigned x, unsigned& nloc, unsigned& nx) {
    const unsigned G = gridDim.x * gridDim.y * gridDim.z;
    unsigned sum, cnt, mine, sp = 0u;
    for (;;) {
        sum = 0u; cnt = 0u; mine = 0u;
#pragma unroll
        for (unsigned j = 0; j < 16; ++j) { const unsigned c = xb_ld(&bar[XB_XCNT(j)]); sum += c; cnt += (c > 0u) ? 1u : 0u; mine = (j == x) ? c : mine; }
        if (sum == G) break;
        __builtin_amdgcn_s_sleep(1);
        if ((++sp & 255u) == 0u) { if (xb_ld(&bar[XB_TMO])) break; if (sp > XB_SPIN_CAP) { atomicAdd(&bar[XB_TMO], 1u); break; } }
    }
    nloc = mine > 0u ? mine : 1u; nx = cnt > 0u ? cnt : 1u;
}
__device__ __forceinline__ void xcd_barrier(const XcdBarrier& b) {
    asm volatile("s_waitcnt vmcnt(0)" ::: "memory");
    __syncthreads();
    if (threadIdx.x == 0) {
        unsigned* bar = b.bar;
        __builtin_amdgcn_s_waitcnt(0);
        unsigned nloc = b.st[0], nx = b.st[1];
        if (nloc == 0u) { xcd_barrier_complete(bar, b.x, nloc, nx); b.st[0] = nloc; b.st[1] = nx; }
        const unsigned old = xb_add(&bar[XB_XSUB(b.x)], 1u);
        const unsigned gen = old / nloc;
        if (old + 1u == (gen + 1u) * nloc) {
            __builtin_amdgcn_fence(__ATOMIC_RELEASE, "agent");
            asm volatile("s_waitcnt vmcnt(0)" ::: "memory");
            const unsigned og = xb_add(&bar[XB_TOP], 1u);
            const unsigned tg = og / nx;
            if (og + 1u == (tg + 1u) * nx) xb_add(&bar[XB_TOPGEN], 1u);
            else XB_SPIN(xb_ld(&bar[XB_TOPGEN]) == tg, bar);
            __builtin_amdgcn_fence(__ATOMIC_ACQUIRE, "agent");
            xb_add(&bar[XB_XGEN(b.x)], 1u);
            asm volatile("s_waitcnt vmcnt(0)" ::: "memory");
        } else {
            XB_SPIN(xb_ld(&bar[XB_XGEN(b.x)]) == gen, bar);
            __builtin_amdgcn_fence(__ATOMIC_ACQUIRE, "agent");
            asm volatile("s_waitcnt vmcnt(0)" ::: "memory");
        }
    }
    __syncthreads();
}

__global__ void __launch_bounds__(NT, 2) mk_fwd(Params p) {
    extern __shared__ __attribute__((aligned(16))) unsigned char lds_raw[];
    LAS unsigned char* lds = (LAS unsigned char*)lds_raw;
    cg::grid_group grid = cg::this_grid();
    const int tid = threadIdx.x, lane = tid & 63, wave = __builtin_amdgcn_readfirstlane(tid >> 6);
    const int G = gridDim.x, gw = blockIdx.x * NWAVES + wave, NGW = G * NWAVES;
    unsigned char* ws = p.ws;
    volatile LAS unsigned* bst = (volatile LAS unsigned*)(lds + LDS_BYTES - 64);
    if (tid < 2) bst[tid] = 0u;
    __syncthreads();
    XcdBarrier xbar = xcd_barrier_post((unsigned*)(ws + WS_BAR), bst);
#ifdef PROBE_K
    unsigned long long pb_t0 = 0, pb_acc = 0;
#define PB_BEGIN(k) do { if (PROBE_K == (k)) pb_t0 = __builtin_amdgcn_s_memrealtime(); } while (0)
#define PB_END(k) do { if (PROBE_K == (k)) pb_acc += __builtin_amdgcn_s_memrealtime() - pb_t0; } while (0)
#else
#define PB_BEGIN(k) do {} while (0)
#define PB_END(k) do {} while (0)
#endif
#define GRID_BAR() xcd_barrier(xbar)

    PB_BEGIN(0);
#ifndef NO_P0
    phase0(p, lds, gw, NGW, wave, lane);
#endif
    if (p.ws == nullptr) grid.sync();
    GRID_BAR();
    PB_END(0);
    PB_BEGIN(1);
#ifndef NO_P1
    phase1(p, gw, NGW, lane);
#endif
    GRID_BAR();
    PB_END(1);
    PB_BEGIN(2);
    {
        pg8::Gemm g{(const bf16_t*)(ws + WS_A), (const bf16_t*)(ws + WS_WIN), D, D};
        pg8::Order S; S.init(M / 256, INW / 256, G, (int)blockIdx.x, (MC / 256) * 4);
        pg8::Epi1 E{(bf16_t*)(ws + WS_P), (bf16_t*)(ws + WS_VT), (bf16_t*)(ws + WS_KC), (bf16_t*)(ws + WS_VTC)};
#ifndef NO_G1
#ifdef STAGGER_US
        {
            const unsigned long long t0 = __builtin_amdgcn_s_memrealtime(); const unsigned long long d = (unsigned long long)(((blockIdx.x >> 3) * 5u) & 15u) * (STAGGER_US * 100ull / 16ull);
            while (__builtin_amdgcn_s_memrealtime() - t0 < d) __builtin_amdgcn_s_sleep(4);
        }
#endif
        pg8::gemm_phase<pg8::Epi1>(lds, g, S, E);
#endif
    }
    GRID_BAR();
    PB_END(2);
    PB_BEGIN(3);
#ifndef NO_P3
    PB_BEGIN(30);
    phase3(p, lds, ((G % 8 == 0) ? (int)((blockIdx.x % 8) * (G / 8) + blockIdx.x / 8) : (int)blockIdx.x) * NWAVES + wave, NGW, lane);
    __syncthreads();
    PB_END(30);
    PB_BEGIN(31);
    phase3b(p, gw, NGW, lane);
#endif
    GRID_BAR();
    PB_END(31);
    PB_END(3);
    PB_BEGIN(4);
    {
        pg8::Gemm g{(const bf16_t*)(ws + WS_A), (const bf16_t*)(ws + WS_WCAT), D, D};
        pg8::Order S; S.init(M / 256, D / 256, G, (int)blockIdx.x, 0);
        pg8::Epi2 E{(const bf16_t*)(ws + WS_P), (bf16_t*)(ws + WS_Z)};
#ifndef NO_G2
        pg8::gemm_phase<pg8::Epi2>(lds, g, S, E);
#endif
    }
    GRID_BAR();
    PB_END(4);
    PB_BEGIN(5);
    {
        pg8::Gemm g{(const bf16_t*)(ws + WS_Z), (const bf16_t*)(ws + WS_WO), D, D};
        pg8::Order S; S.init(M / 256, D / 256, G, (int)blockIdx.x, 0);
        pg8::EpiStore<true, D, false> E{(bf16_t*)(ws + WS_A), (float*)(ws + WS_SS1)};
#ifndef NO_G3
        pg8::gemm_phase<pg8::EpiStore<true, D, false>>(lds, g, S, E);
#endif
    }
    GRID_BAR();
    PB_END(5);
    PB_BEGIN(6);
#ifndef NO_P6
    phase6(p, gw, NGW, lane);
#endif
    GRID_BAR();
    PB_END(6);
    PB_BEGIN(7);
    {
        pg8::Gemm g{(const bf16_t*)(ws + WS_H2), (const bf16_t*)(ws + WS_WUP), D, D};
        pg8::Order S; S.init(M / 256, UPW / 256, G, (int)blockIdx.x, 0);
        pg8::EpiAct E{(bf16_t*)(ws + WS_ACT), (float*)(ws + WS_SBG), (float*)(ws + WS_SBP), (float*)(ws + WS_SBA), p.w_ffn_conv, p.b_ffn_conv};
#ifndef NO_G4
        pg8::gemm_phase<pg8::EpiAct>(lds, g, S, E);
#endif
    }
    GRID_BAR();
    PB_END(7);
    PB_BEGIN(9);
    {
        pg8::Gemm g{(const bf16_t*)(ws + WS_ACT), (const bf16_t*)(ws + WS_WDN), DFF, DFF};
        pg8::Order S; S.init(M / 256, D / 256, G, (int)blockIdx.x, 0);
#ifndef NO_P8
        { pg8::Unit uu; int lastpm = -1;
          for (int i = 0; S.next(i, uu); ++i) { if (uu.pm != lastpm) { act_fixup_panel(p, uu.pm, tid); lastpm = uu.pm; } }
          asm volatile("s_waitcnt vmcnt(0)" ::: "memory"); __syncthreads(); }
#endif
        pg8::EpiStore<true, D, false> E{(bf16_t*)(ws + WS_Y2), (float*)(ws + WS_SS2)};
#ifndef NO_G3
        pg8::gemm_phase<pg8::EpiStore<true, D, false>>(lds, g, S, E);
#endif
    }
    GRID_BAR();
    PB_END(9);
    PB_BEGIN(10);
    phase10(p, gw, NGW, lane);
    PB_END(10);
#ifdef PROBE_K
    if (blockIdx.x == 0 && tid == 0) { const unsigned long long t0 = __builtin_amdgcn_s_memrealtime(); while (__builtin_amdgcn_s_memrealtime() - t0 < 3ull * pb_acc) __builtin_amdgcn_s_sleep(8); }
#endif
}

extern "C" void kernel_launch(void* const* d_in, const int* in_sizes, int n_in, void* d_out, int out_size, void* d_ws, size_t ws_size, hipStream_t stream) {
    static int grid = 0;
    if (grid == 0) {
        if (n_in != 20 || in_sizes[0] != M * D || out_size != M * D || ws_size < WS_END) {
            fprintf(stderr, "kernel_launch: unexpected shapes (n_in %d, in0 %d, out %d, ws %zu; need ws >= %zu); nothing launched\n", n_in, n_in > 0 ? in_sizes[0] : -1, out_size, ws_size, (size_t)WS_END);
            grid = -1; return; }
        int dev = 0, cus = 0, per_cu = 0;
        hipGetDevice(&dev);
        hipDeviceGetAttribute(&cus, hipDeviceAttributeMultiprocessorCount, dev);
        if (hipFuncSetAttribute((const void*)mk_fwd, hipFuncAttributeMaxDynamicSharedMemorySize, LDS_BYTES) != hipSuccess) { fprintf(stderr, "kernel_launch: hipFuncSetAttribute failed\n"); grid = -1; return; }
        if (hipOccupancyMaxActiveBlocksPerMultiprocessor(&per_cu, (const void*)mk_fwd, NT, LDS_BYTES) != hipSuccess || per_cu < 1) { fprintf(stderr, "kernel_launch: occupancy query says %d\n", per_cu); per_cu = 1; }
        (void)hipGetLastError();
        grid = cus * per_cu;
    }
    if (grid < 0) return;
    Params p{};
    p.x = (const float*)d_in[0]; p.c = (const float*)d_in[1]; p.ctx = (const float*)d_in[2]; p.c_ctx = (const float*)d_in[3];
    p.w_ada = (const float*)d_in[4]; p.b_ada = (const float*)d_in[5]; p.g_pre_mix = (const float*)d_in[6]; p.g_post_mix = (const float*)d_in[7];
    p.g_pre_ffn = (const float*)d_in[8]; p.g_post_ffn = (const float*)d_in[9]; p.w_in = (const float*)d_in[10]; p.rpb = (const float*)d_in[11];
    p.w_short_conv = (const float*)d_in[12]; p.w_branch_attn = (const float*)d_in[13]; p.w_branch_conv = (const float*)d_in[14]; p.w_out = (const float*)d_in[15];
    p.w_up = (const float*)d_in[16]; p.w_ffn_conv = (const float*)d_in[17]; p.b_ffn_conv = (const float*)d_in[18]; p.w_down = (const float*)d_in[19];
    p.out = (float*)d_out; p.ws = (unsigned char*)d_ws;
    (void)hipMemsetAsync((char*)d_ws + WS_BAR, 0, 16384, stream);
    void* args[] = {&p};
    hipError_t e = hipLaunchCooperativeKernel((const void*)mk_fwd, dim3(grid), dim3(NT), args, LDS_BYTES, stream);
    if (e != hipSuccess) fprintf(stderr, "kernel_launch: cooperative launch failed: %s (grid %d)\n", hipGetErrorString(e), grid);
}
```
